# Optimizing an MI355X kernel written in HIP

```python
import jax
import jax.numpy as jnp
from jax import lax
import numpy as np

D_MODEL = 1024
BATCH = 32
SEQ = 256
DEPTH = 2
DEC_BATCH = 8
DEC_SEQ = 4096
PAST_LEN = 512

GRID_W = 64
N_MIXERS = 2
N_MLSTM_LAYERS = (DEPTH + 1) // 2
N_ATTN_LAYERS = DEPTH // 2
D_FF = 2816
FFN_RES = 0.5
NH_M = 8
DK_M = 64
DV_M = 128
MLSTM_CHUNK = 128
NH_A = 16
NKV_A = 4
G_A = NH_A // NKV_A
HD_A = 64
WINDOW = 128
ATTN_BLOCK = 128
ROPE_THETA = 10000.0
EPS = 1e-6
NEG_INF = -1e30
N_MOD = 9
M_IN = 2 * NH_M * DK_M + 2 * NH_M * DV_M + 4 * NH_M
A_IN = (NH_A + 2 * NKV_A) * HD_A

kernel_name = "hybrid_mlstm_swa_macaron_dit_step"


def _rmsnorm(x, g):
    xf = x.astype(jnp.float32)
    y = xf * lax.rsqrt(jnp.mean(xf * xf, axis=-1, keepdims=True) + EPS)
    return (y * g.astype(jnp.float32)).astype(x.dtype)


def _adaln(cond, w_mod, b_mod):
    return (jax.nn.silu(cond) @ w_mod + b_mod).reshape(cond.shape[0], N_MOD, D_MODEL)


def _modulated_norm(x, g, shift, scale):
    return _rmsnorm(x, g) * (1 + scale[:, None, :]) + shift[:, None, :]


def _swiglu(h, w_gu, w_down):
    gate, up = jnp.split(h @ w_gu, 2, axis=-1)
    return (jax.nn.silu(gate) * up) @ w_down


def _ffn_sub(x, mod, j, g, w_gu, w_down):
    shift, scale, gate = mod[:, 3 * j], mod[:, 3 * j + 1], mod[:, 3 * j + 2]
    return x + FFN_RES * gate[:, None, :] * _swiglu(_modulated_norm(x, g, shift, scale), w_gu, w_down)


def _mlstm_chunkwise(q, k, v, log_i, log_f, c0, n0, m0):
    bsz, n_tok, nh, _ = q.shape
    dv = v.shape[-1]
    nc = n_tok // MLSTM_CHUNK

    def chunks(a):
        a = a.reshape((bsz, nc, MLSTM_CHUNK) + a.shape[2:])
        return jnp.moveaxis(jnp.moveaxis(a, 1, 0), 3, 2)

    tril = jnp.tril(jnp.ones((MLSTM_CHUNK, MLSTM_CHUNK), bool))

    def step(carry, xs):
        c, n, m = carry
        qc, kc, vc, li, lf = xs
        b = jnp.cumsum(lf, axis=-1)
        d = jnp.where(tril, b[..., :, None] - b[..., None, :] + li[..., None, :], -jnp.inf)
        m_inter = b + m[..., None]
        m_t = jnp.maximum(jnp.max(d, axis=-1), m_inter)
        w = jnp.einsum('bhtd,bhsd->bhts', qc, kc) * jnp.exp(d - m_t[..., None])
        inter = jnp.exp(m_inter - m_t)
        num = jnp.einsum('bhts,bhsv->bhtv', w, vc) + inter[..., None] * jnp.einsum('bhtd,bhdv->bhtv', qc, c)
        den = jnp.sum(w, axis=-1) + inter * jnp.einsum('bhtd,bhd->bht', qc, n)
        h = num / jnp.maximum(jnp.abs(den), jnp.exp(-m_t))[..., None]
        b_end = b[..., -1]
        to_end = b_end[..., None] - b + li
        m_new = jnp.maximum(b_end + m, jnp.max(to_end, axis=-1))
        w_end = jnp.exp(to_end - m_new[..., None])
        keep = jnp.exp(b_end + m - m_new)
        c_new = keep[..., None, None] * c + jnp.einsum('bhs,bhsd,bhsv->bhdv', w_end, kc, vc)
        n_new = keep[..., None] * n + jnp.einsum('bhs,bhsd->bhd', w_end, kc)
        return (c_new, n_new, m_new), h

    xs = (chunks(q), chunks(k), chunks(v), chunks(log_i), chunks(log_f))
    (c_f, n_f, m_f), h = lax.scan(step, (c0, n0, m0), xs)
    h = jnp.swapaxes(jnp.moveaxis(h, 0, 1), 2, 3).reshape(bsz, n_tok, nh, dv)
    return h, c_f, n_f, m_f


def _mlstm_mixer(h, w_in, b_gate, g_head, w_out, c0, n0, m0):
    f32 = jnp.float32
    bsz, n_tok, _ = h.shape
    qk_w, v_w = NH_M * DK_M, NH_M * DV_M
    q, k, v, o, gates = jnp.split(h @ w_in, [qk_w, 2 * qk_w, 2 * qk_w + v_w, 2 * qk_w + 2 * v_w], axis=-1)
    q = q.reshape(bsz, n_tok, NH_M, DK_M).astype(f32) * DK_M ** -0.5
    k = k.reshape(bsz, n_tok, NH_M, DK_M).astype(f32)
    v = v.reshape(bsz, n_tok, NH_M, DV_M).astype(f32)
    gates = (gates.astype(f32) + b_gate.astype(f32)).reshape(bsz, n_tok, 2, 2, NH_M)
    log_i = gates[:, :, :, 0]
    log_f = jax.nn.log_sigmoid(gates[:, :, :, 1])
    c0, n0, m0 = c0.astype(f32), n0.astype(f32), m0.astype(f32)
    h_f, c_f, n_f, m_f = _mlstm_chunkwise(q, k, v, log_i[:, :, 0], log_f[:, :, 0], c0[:, 0], n0[:, 0], m0[:, 0])
    rev = lambda a: jnp.flip(a, axis=1)
    h_b, c_b, n_b, m_b = _mlstm_chunkwise(rev(q), rev(k), rev(v), rev(log_i[:, :, 1]), rev(log_f[:, :, 1]),
                                          c0[:, 1], n0[:, 1], m0[:, 1])
    hs = h_f + rev(h_b)
    hs = hs * lax.rsqrt(jnp.mean(hs * hs, axis=-1, keepdims=True) + EPS) * g_head.astype(f32).reshape(NH_M, DV_M)
    out = (hs.reshape(bsz, n_tok, v_w).astype(h.dtype) * jax.nn.sigmoid(o)) @ w_out
    dt = h.dtype
    return (out, jnp.stack([c_f, c_b], axis=1).astype(dt), jnp.stack([n_f, n_b], axis=1).astype(dt),
            jnp.stack([m_f, m_b], axis=1).astype(dt))


def _attn_project(h, w_in):
    bsz, n_tok, _ = h.shape
    q, k, v = jnp.split(h @ w_in, [NH_A * HD_A, (NH_A + NKV_A) * HD_A], axis=-1)
    return (q.reshape(bsz, n_tok, NKV_A, G_A, HD_A), k.reshape(bsz, n_tok, NKV_A, HD_A),
            v.reshape(bsz, n_tok, NKV_A, HD_A))


def _axial_rope_tables(n_rows):
    quarter = HD_A // 4
    freqs = ROPE_THETA ** (-jnp.arange(quarter, dtype=jnp.float32) / quarter)
    row = jnp.repeat(jnp.arange(n_rows, dtype=jnp.float32), GRID_W)
    col = jnp.tile(jnp.arange(GRID_W, dtype=jnp.float32), n_rows)
    ang_r, ang_c = row[:, None] * freqs, col[:, None] * freqs
    ang = jnp.concatenate([ang_r, ang_r, ang_c, ang_c], axis=-1)
    return jnp.cos(ang), jnp.sin(ang)


def _axial_rope(x, cos, sin):
    shp = (cos.shape[0],) + (1,) * (x.ndim - 3) + (HD_A,)
    cs, sn = cos.reshape(shp).astype(x.dtype), sin.reshape(shp).astype(x.dtype)
    xr = x.reshape(x.shape[:-1] + (2, 2, HD_A // 4))
    rot = jnp.stack([-xr[..., 1, :], xr[..., 0, :]], axis=-2).reshape(x.shape)
    return x * cs + rot * sn


def _sink_softmax_attend(qb, k, v, sink, mask):
    s = jnp.einsum('blkgd,bskd->bkgls', qb, k).astype(jnp.float32) * HD_A ** -0.5
    if mask is not None:
        s = jnp.where(mask, s, NEG_INF)
    sink_col = jnp.broadcast_to(sink.astype(jnp.float32).reshape(1, NKV_A, G_A, 1, 1), s.shape[:-1] + (1,))
    p = jax.nn.softmax(jnp.concatenate([s, sink_col], axis=-1), axis=-1)[..., :-1]
    return jnp.einsum('bkgls,bskd->blkgd', p.astype(v.dtype), v)


def _attn_context(q, k, v, sink):
    bsz, n_ctx = q.shape[:2]

    def block(j):
        qb = lax.dynamic_slice_in_dim(q, j * ATTN_BLOCK, ATTN_BLOCK, axis=1)
        return _sink_softmax_attend(qb, k, v, sink, None)

    out = lax.map(block, jnp.arange(n_ctx // ATTN_BLOCK))
    return jnp.moveaxis(out, 0, 1).reshape(bsz, n_ctx, NH_A * HD_A)


def _attn_latent(q, k, v, k_ctx, v_ctx, sink):
    bsz, n_tok = q.shape[:2]
    n_ctx = k_ctx.shape[1]
    pad = ((0, 0), (ATTN_BLOCK, ATTN_BLOCK), (0, 0), (0, 0))
    k_pad, v_pad = jnp.pad(k, pad), jnp.pad(v, pad)
    ctx_mask = jnp.ones((ATTN_BLOCK, n_ctx), bool)

    def block(j):
        start = j * ATTN_BLOCK
        qb = lax.dynamic_slice_in_dim(q, start, ATTN_BLOCK, axis=1)
        kb = lax.dynamic_slice_in_dim(k_pad, start, 3 * ATTN_BLOCK, axis=1)
        vb = lax.dynamic_slice_in_dim(v_pad, start, 3 * ATTN_BLOCK, axis=1)
        t_pos = start + jnp.arange(ATTN_BLOCK)
        s_pos = start - ATTN_BLOCK + jnp.arange(3 * ATTN_BLOCK)
        local = ((jnp.abs(t_pos[:, None] - s_pos[None, :]) <= WINDOW)
                 & (s_pos >= 0)[None, :] & (s_pos < n_tok)[None, :])
        mask = jnp.concatenate([local, ctx_mask], axis=1)
        return _sink_softmax_attend(qb, jnp.concatenate([kb, k_ctx], axis=1),
                                    jnp.concatenate([vb, v_ctx], axis=1), sink, mask)

    out = lax.map(block, jnp.arange(n_tok // ATTN_BLOCK))
    return jnp.moveaxis(out, 0, 1).reshape(bsz, n_tok, NH_A * HD_A)


def setup_inputs(seed: int = 0) -> dict:
    key = jax.random.key(seed)
    ks = jax.random.split(key, 24)
    f32 = jnp.float32
    nrm = lambda kk, shp: jax.random.normal(kk, shp, f32)
    D = D_MODEL
    gate_base = jnp.tile(jnp.concatenate([jnp.full((NH_M,), -1.0, f32), jnp.full((NH_M,), 3.0, f32)]), 2)
    return {
        "x_prompt": nrm(ks[0], (BATCH, SEQ, D)),
        "x_sample": nrm(ks[1], (DEC_BATCH, DEC_SEQ, D)),
        "state_c": 0.5 * nrm(ks[2], (DEC_BATCH, N_MLSTM_LAYERS, 2, NH_M, DK_M, DV_M)),
        "state_n": 0.5 * nrm(ks[3], (DEC_BATCH, N_MLSTM_LAYERS, 2, NH_M, DK_M)),
        "state_m": nrm(ks[4], (DEC_BATCH, N_MLSTM_LAYERS, 2, NH_M)),
        "cache_k": nrm(ks[5], (DEC_BATCH, N_ATTN_LAYERS, PAST_LEN, NKV_A, HD_A)),
        "cache_v": nrm(ks[6], (DEC_BATCH, N_ATTN_LAYERS, PAST_LEN, NKV_A, HD_A)),
        "c": nrm(ks[7], (DEC_BATCH, D)),
        "c_ctx": nrm(ks[8], (D,)),
        "w_mod": 0.5 * D ** -0.5 * nrm(ks[9], (DEPTH, D, N_MOD * D)),
        "b_mod": 0.02 * nrm(ks[10], (DEPTH, N_MOD * D)),
        "norm_g": 1.0 + 0.02 * nrm(ks[11], (DEPTH, 3, D)),
        "ffn1_w_gu": D ** -0.5 * nrm(ks[12], (DEPTH, D, 2 * D_FF)),
        "ffn1_w_down": D_FF ** -0.5 * nrm(ks[13], (DEPTH, D_FF, D)),
        "ffn2_w_gu": D ** -0.5 * nrm(ks[14], (DEPTH, D, 2 * D_FF)),
        "ffn2_w_down": D_FF ** -0.5 * nrm(ks[15], (DEPTH, D_FF, D)),
        "mlstm_w_in": D ** -0.5 * nrm(ks[16], (N_MLSTM_LAYERS, D, M_IN)),
        "mlstm_b_gate": gate_base[None, :] + 0.1 * nrm(ks[17], (N_MLSTM_LAYERS, 4 * NH_M)),
        "mlstm_g_head": 1.0 + 0.02 * nrm(ks[18], (N_MLSTM_LAYERS, NH_M * DV_M)),
        "mlstm_w_out": (NH_M * DV_M) ** -0.5 * nrm(ks[19], (N_MLSTM_LAYERS, NH_M * DV_M, D)),
        "attn_w_in": D ** -0.5 * nrm(ks[20], (N_ATTN_LAYERS, D, A_IN)),
        "attn_sink": 0.5 * nrm(ks[21], (N_ATTN_LAYERS, NH_A)),
        "attn_w_out": (NH_A * HD_A) ** -0.5 * nrm(ks[22], (N_ATTN_LAYERS, NH_A * HD_A, D)),
        "final_g": 1.0 + 0.02 * nrm(ks[23], (D,)),
    }


def reference(x_prompt, x_sample, state_c, state_n, state_m, cache_k, cache_v, c, c_ctx, w_mod, b_mod, norm_g,
              ffn1_w_gu, ffn1_w_down, ffn2_w_gu, ffn2_w_down, mlstm_w_in, mlstm_b_gate, mlstm_g_head, mlstm_w_out,
              attn_w_in, attn_sink, attn_w_out, final_g):
    n_rows = x_sample.shape[1] // GRID_W
    cos, sin = _axial_rope_tables(n_rows)
    bp = x_prompt.shape[0]
    xp, xs = x_prompt, x_sample
    new_c, new_n, new_m, new_k, new_v = [], [], [], [], []
    for l in range(DEPTH):
        mod_p = _adaln(c_ctx[None, :], w_mod[l], b_mod[l])
        mod_s = _adaln(c, w_mod[l], b_mod[l])
        xp = _ffn_sub(xp, mod_p, 0, norm_g[l, 0], ffn1_w_gu[l], ffn1_w_down[l])
        xs = _ffn_sub(xs, mod_s, 0, norm_g[l, 0], ffn1_w_gu[l], ffn1_w_down[l])
        hp = _modulated_norm(xp, norm_g[l, 1], mod_p[:, 3], mod_p[:, 4])
        hs = _modulated_norm(xs, norm_g[l, 1], mod_s[:, 3], mod_s[:, 4])
        i = l // N_MIXERS
        if l % N_MIXERS == 0:
            zc = jnp.zeros((bp, 2, NH_M, DK_M, DV_M), xp.dtype)
            zn = jnp.zeros((bp, 2, NH_M, DK_M), xp.dtype)
            zm = jnp.zeros((bp, 2, NH_M), xp.dtype)
            out_p, sc, sn, sm = _mlstm_mixer(hp, mlstm_w_in[i], mlstm_b_gate[i], mlstm_g_head[i], mlstm_w_out[i],
                                             zc, zn, zm)
            out_s, _, _, _ = _mlstm_mixer(hs, mlstm_w_in[i], mlstm_b_gate[i], mlstm_g_head[i], mlstm_w_out[i],
                                          state_c[:, i], state_n[:, i], state_m[:, i])
            new_c.append(sc)
            new_n.append(sn)
            new_m.append(sm)
        else:
            qp, kp, vp = _attn_project(hp, attn_w_in[i])
            out_p = _attn_context(qp, kp, vp, attn_sink[i]) @ attn_w_out[i]
            qs, ks_, vs = _attn_project(hs, attn_w_in[i])
            qs, ks_ = _axial_rope(qs, cos, sin), _axial_rope(ks_, cos, sin)
            out_s = _attn_latent(qs, ks_, vs, cache_k[:, i], cache_v[:, i], attn_sink[i]) @ attn_w_out[i]
            new_k.append(kp)
            new_v.append(vp)
        xp = xp + mod_p[:, 5][:, None, :] * out_p
        xs = xs + mod_s[:, 5][:, None, :] * out_s
        xp = _ffn_sub(xp, mod_p, 2, norm_g[l, 2], ffn2_w_gu[l], ffn2_w_down[l])
        xs = _ffn_sub(xs, mod_s, 2, norm_g[l, 2], ffn2_w_gu[l], ffn2_w_down[l])
    y_prompt = _rmsnorm(xp, final_g)
    y_sample = _rmsnorm(xs, final_g)
    new_state_c = jnp.stack(new_c, axis=1)
    new_state_n = jnp.stack(new_n, axis=1)
    new_state_m = jnp.stack(new_m, axis=1)
    new_cache_k = jnp.stack(new_k, axis=1)
    new_cache_v = jnp.stack(new_v, axis=1)
    return (y_prompt, y_sample, new_state_c, new_state_n, new_state_m, new_cache_k, new_cache_v)
```

```cpp
#include <hip/hip_runtime.h>
#include <hip/hip_cooperative_groups.h>
#include <cstdio>
#include <cstdint>
namespace cg = cooperative_groups;
namespace pg8 {
#define PG8_LAS __attribute__((address_space(3)))
typedef unsigned short bf16_t;
typedef short bf16x8 __attribute__((ext_vector_type(8)));
typedef float f32x4 __attribute__((ext_vector_type(4)));
typedef unsigned u32x4 __attribute__((ext_vector_type(4)));
constexpr int BM = 256, BK = 64, HALF = 128, HTB = HALF * BK * 2  , STAGE_BYTES = 8 * HTB, NXCD = 8, WGM = 8;

__host__ __device__ __forceinline__ int lds_byte(int r, int c) { const int st = (r >> 4) * 2 + (c >> 5), rr = r & 15, cc = c & 31, ob = rr * 64 + cc * 2; return st * 1024 + (ob ^ (((ob >> 9) & 1) << 5)); }
__host__ __device__ __forceinline__ void stage_rc(int b, int& R, int& C) { const int st = b / 1024, sb = b % 1024, swz = sb ^ (((sb >> 9) & 1) << 5); R = (st >> 1) * 16 + swz / 64; C = (st & 1) * 32 + (swz % 64) / 2; }
__host__ __device__ __forceinline__ int perm32(int rho) { const int n = rho >> 4, i = rho & 15; return 8 * (i >> 2) + 4 * n + (i & 3); }

typedef _Float16 f16x8 __attribute__((ext_vector_type(8)));
template <bool F16> __device__ __forceinline__ f32x4 mma16(bf16x8 a, bf16x8 b, f32x4 c) {
    if constexpr (F16) return __builtin_amdgcn_mfma_f32_16x16x32_f16(__builtin_bit_cast(f16x8, a), __builtin_bit_cast(f16x8, b), c, 0, 0, 0);
    else return __builtin_amdgcn_mfma_f32_16x16x32_bf16(a, b, c, 0, 0, 0);
}
struct Unit { int pm, pn; };
struct Gemm { const bf16_t* A; const bf16_t* Bt; int M, N, K; };

struct StaticOrder {
    int nM, nN, nwg, G, c;
    __host__ __device__ void init(int M, int N, int G_, int c_) { nM = M / BM; nN = N / BM; nwg = nM * nN; G = G_; c = c_; }
    __host__ __device__ bool next(int i, Unit& u) const {
        const long L = (long)i * G + c; if (L >= nwg) return false;
        int wgid = (int)L; { const int q = nwg / NXCD, r = nwg % NXCD, xcd = wgid % NXCD, off = wgid / NXCD; wgid = (xcd < r ? xcd * (q + 1) : r * (q + 1) + (xcd - r) * q) + off; }
        const int nig = WGM * nN, gid = wgid / nig, fm = gid * WGM, gsz = (nM - fm) < WGM ? (nM - fm) : WGM;
        u.pm = fm + ((wgid % nig) % gsz); u.pn = (wgid % nig) / gsz; return true;
    }
    __device__ __forceinline__ void a_ready(const Unit&) const {}
    __device__ __forceinline__ void done(const Unit&) const {}
};

__device__ __forceinline__ unsigned cvt_pk_bf16(float lo, float hi) { unsigned r; asm volatile("v_cvt_pk_bf16_f32 %0, %1, %2" : "=v"(r) : "v"(lo), "v"(hi)); return r; }
typedef float f32x2 __attribute__((ext_vector_type(2)));
__device__ __forceinline__ f32x2 gelu_pk(f32x2 v) {
    const f32x2 av = __builtin_elementwise_abs(v), d = av * 0.2316418882f + 1.0f;
    f32x2 t; t.x = __builtin_amdgcn_rcpf(d.x); t.y = __builtin_amdgcn_rcpf(d.y);
    f32x2 q = t * 0.5307027145f + (-0.7265760135f); q = q * t + 0.7107068705f; q = q * t + (-0.142248368f); q = q * t + 0.127414796f; q = q * t;
    const f32x2 s = (v * v) * (-0.72134752044f);
    f32x2 e; e.x = __builtin_amdgcn_exp2f(s.x); e.y = __builtin_amdgcn_exp2f(s.y);
    const f32x2 m = v * (q * e), r = v - m;
    f32x2 o; o.x = v.x < 0.f ? m.x : r.x; o.y = v.y < 0.f ? m.y : r.y; return o;
}

template <int ACT  > struct EpiBf16 {
    static constexpr bool PERM = true, AFTER_DRAIN = false; static_assert(ACT == 0 || ACT == 1, "EpiBf16: ACT is 0 (none) or 1 (gelu_pk)");
    bf16_t* O; int ldc; const float* bias; int split_cols; size_t split_stride; float scale0;
    __device__ __forceinline__ void operator()(const f32x4 (&acc)[2][2][4][2], const Unit& u, int wr, int wc, int fr, int fq) const {
        const int row0 = u.pm * BM + wr * 64 + fr; int colt = u.pn * BM; bf16_t* base = O;
        float sc = 1.f; if (split_cols) { const int t = colt / split_cols; base += (size_t)t * split_stride; colt -= t * split_cols; if (t == 0) sc = scale0; }
        const int col0 = colt + wc * 32 + 8 * fq, bcol0 = u.pn * BM + wc * 32 + 8 * fq;
        f32x4 bv[2][2];
#pragma unroll
        for (int bj = 0; bj < 2; ++bj)
#pragma unroll
            for (int n = 0; n < 2; ++n) bv[bj][n] = bias ? *(const f32x4*)(bias + bcol0 + bj * HALF + 4 * n) : (f32x4){0.f, 0.f, 0.f, 0.f};
#pragma unroll
        for (int ai = 0; ai < 2; ++ai)
#pragma unroll
            for (int m = 0; m < 4; ++m) { bf16_t* rowp = base + (size_t)(row0 + ai * HALF + m * 16) * ldc + col0;
#pragma unroll
                for (int bj = 0; bj < 2; ++bj) { f32x4 v0 = acc[ai][bj][m][0] + bv[bj][0], v1 = acc[ai][bj][m][1] + bv[bj][1];
                    if (ACT == 1) { f32x2 a = gelu_pk((f32x2){v0[0], v0[1]}), b = gelu_pk((f32x2){v0[2], v0[3]}), c = gelu_pk((f32x2){v1[0], v1[1]}), d = gelu_pk((f32x2){v1[2], v1[3]});
                        v0 = (f32x4){a.x, a.y, b.x, b.y}; v1 = (f32x4){c.x, c.y, d.x, d.y}; }
                    v0 = v0 * sc; v1 = v1 * sc; u32x4 w; w.x = cvt_pk_bf16(v0[0], v0[1]); w.y = cvt_pk_bf16(v0[2], v0[3]); w.z = cvt_pk_bf16(v1[0], v1[1]); w.w = cvt_pk_bf16(v1[2], v1[3]);
                    *(u32x4*)(rowp + bj * HALF) = w; } }
    }
};

struct PanelStats {
    unsigned* xbuf;
    unsigned* cnt;
    unsigned* tmo;
    int ntn; float eps;
    unsigned code;
    __device__ __forceinline__ bool run(const f32x4 (&v)[2][2][4][2], const Unit& u, int wr, int wc, int fr, int fq, PG8_LAS unsigned char* lds, int wid, int lane) const {
        typedef float f32x2v __attribute__((ext_vector_type(2)));
        PG8_LAS f32x2v* P = (PG8_LAS f32x2v*)lds;
        PG8_LAS f32x2v* S = (PG8_LAS f32x2v*)(lds + 8192);
        PG8_LAS unsigned* flag = (PG8_LAS unsigned*)(lds + 8192 + 2048);
#pragma unroll
        for (int ai = 0; ai < 2; ++ai)
#pragma unroll
            for (int m = 0; m < 4; ++m) {
                float s = 0.f;
#pragma unroll
                for (int bj = 0; bj < 2; ++bj)
#pragma unroll
                    for (int n = 0; n < 2; ++n) { const f32x4 x = v[ai][bj][m][n]; s += (x[0] + x[1]) + (x[2] + x[3]); }
                s += __shfl_xor(s, 16); s += __shfl_xor(s, 32);
                const float mw = s * (1.0f / 64.0f); float q = 0.f;
#pragma unroll
                for (int bj = 0; bj < 2; ++bj)
#pragma unroll
                    for (int n = 0; n < 2; ++n) { const f32x4 d = v[ai][bj][m][n] - mw; q += (d[0] * d[0] + d[1] * d[1]) + (d[2] * d[2] + d[3] * d[3]); }
                q += __shfl_xor(q, 16); q += __shfl_xor(q, 32);
                if (fq == 0) P[(ai * HALF + wr * 64 + m * 16 + fr) * 4 + wc] = (f32x2v){mw, q};
            }
        asm volatile("s_waitcnt lgkmcnt(0)" ::: "memory"); __builtin_amdgcn_s_barrier(); asm volatile("" ::: "memory");
#if defined(BROKEN_EXCHANGE_NO_WAIT)
#warning BROKEN CONTROL BUILD: the row-statistics exchange does not wait; results are wrong by design
        if (blockIdx.x >= 64) { const long long t0_ = clock64(); while (clock64() - t0_ < 60000) __builtin_amdgcn_s_sleep(8); }
#endif
        const int row = wid * 32 + (lane & 31);
        if (lane < 32) {
            const f32x2v a = P[row * 4 + 0], b = P[row * 4 + 1], c = P[row * 4 + 2], d = P[row * 4 + 3];
            const float mt = (a.x + b.x + c.x + d.x) * 0.25f;
            const float da = a.x - mt, db = b.x - mt, dc = c.x - mt, dd = d.x - mt;
            const float m2 = (a.y + b.y) + (c.y + d.y) + 64.0f * ((da * da + db * db) + (dc * dc + dd * dd));
            unsigned long long* slot = (unsigned long long*)xbuf + ((size_t)(u.pm * BM + row) * 4 + u.pn);
            __hip_atomic_store(slot, ((unsigned long long)__float_as_uint(m2) << 32) | __float_as_uint(mt), __ATOMIC_RELAXED, __HIP_MEMORY_SCOPE_AGENT);
        }
        asm volatile("s_waitcnt vmcnt(0)" ::: "memory");
        if (lane == 0) __hip_atomic_fetch_add(cnt + 64 * u.pm, 1u, __ATOMIC_RELAXED, __HIP_MEMORY_SCOPE_AGENT);
        if (wid == 0) {
            bool dead = false; const unsigned long long t0 = __builtin_amdgcn_s_memrealtime(); const unsigned want = 8u * (unsigned)ntn;
            for (;;) {
#if defined(BROKEN_EXCHANGE_NO_WAIT)
                break;
#endif
                if ((unsigned)__builtin_amdgcn_readfirstlane(__hip_atomic_load(cnt + 64 * u.pm, __ATOMIC_RELAXED, __HIP_MEMORY_SCOPE_AGENT)) >= want) break;
                if (__builtin_amdgcn_s_memrealtime() - t0 > 2000000ull) {
                    if (lane == 0) { unsigned expect = 0u; __hip_atomic_compare_exchange_strong(tmo + 1, &expect, code | (unsigned)(u.pm & 0xff), __ATOMIC_RELAXED, __ATOMIC_RELAXED, __HIP_MEMORY_SCOPE_AGENT);
                                     __hip_atomic_store(tmo, 1u, __ATOMIC_RELAXED, __HIP_MEMORY_SCOPE_AGENT); }
                    dead = true; break; }
                __builtin_amdgcn_s_sleep(2);
            }
            __builtin_amdgcn_fence(__ATOMIC_ACQUIRE, "agent");
            if (lane == 0) flag[0] = dead ? 1u : 0u;
        }
        asm volatile("s_waitcnt vmcnt(0) lgkmcnt(0)" ::: "memory"); __builtin_amdgcn_s_barrier(); asm volatile("" ::: "memory");
        const bool bad = flag[0] != 0u;
        if (lane < 32) {
            const unsigned long long* slot = (const unsigned long long*)xbuf + (size_t)(u.pm * BM + row) * 4; float mt[4], m2[4]; float ms = 0.f;
#pragma unroll
            for (int t = 0; t < 4; ++t) { if (t < ntn) { const unsigned long long w = __hip_atomic_load(slot + t, __ATOMIC_RELAXED, __HIP_MEMORY_SCOPE_AGENT); mt[t] = __uint_as_float((unsigned)w); m2[t] = __uint_as_float((unsigned)(w >> 32)); } else { mt[t] = 0.f; m2[t] = 0.f; } ms += mt[t]; }
            const float mean = ms / (float)ntn; float q = 0.f;
#pragma unroll
            for (int t = 0; t < 4; ++t) if (t < ntn) { const float dm = mt[t] - mean; q += m2[t] + 256.0f * dm * dm; }
            S[row] = (f32x2v){mean, 1.0f / sqrtf(q / (256.0f * (float)ntn) + eps)};
        }
        asm volatile("s_waitcnt lgkmcnt(0)" ::: "memory"); __builtin_amdgcn_s_barrier(); asm volatile("" ::: "memory");
        return bad;
    }
};
struct EpiLnRes {
    static constexpr bool PERM = false, AFTER_DRAIN = true;
    const float* base; float* out; int ldc; const float* bias; PanelStats st; unsigned poison;
    __device__ __forceinline__ void fused(f32x4 (&acc)[2][2][4][2], const Unit& u, int wr, int wc, int fr, int fq, PG8_LAS unsigned char* lds, int wid, int lane) const {
        typedef float f32x2v __attribute__((ext_vector_type(2)));
        const PG8_LAS f32x2v* S = (const PG8_LAS f32x2v*)(lds + 8192);
        const int col0 = u.pn * BM + wc * 32 + 4 * fq;
#pragma unroll
        for (int bj = 0; bj < 2; ++bj)
#pragma unroll
            for (int n = 0; n < 2; ++n) { const f32x4 bv = bias ? *(const f32x4*)(bias + col0 + bj * HALF + n * 16) : (f32x4){0.f, 0.f, 0.f, 0.f};
#pragma unroll
                for (int ai = 0; ai < 2; ++ai)
#pragma unroll
                    for (int m = 0; m < 4; ++m) acc[ai][bj][m][n] += bv; }
        f32x4 pre[4][2][2];
#pragma unroll
        for (int m = 0; m < 4; ++m) { const size_t off = (size_t)(u.pm * BM + wr * 64 + m * 16 + fr) * ldc + col0;
#pragma unroll
            for (int bj = 0; bj < 2; ++bj)
#pragma unroll
                for (int n = 0; n < 2; ++n) pre[m][bj][n] = *(const f32x4*)(base + off + bj * HALF + n * 16); }
        const bool bad = st.run(acc, u, wr, wc, fr, fq, lds, wid, lane) || poison != 0u;
        const float qnan = __builtin_nanf("");
#pragma unroll
        for (int ai = 0; ai < 2; ++ai)
#pragma unroll
            for (int m = 0; m < 4; ++m) { const int r = ai * HALF + wr * 64 + m * 16 + fr; const f32x2v sr = S[r]; const size_t off = (size_t)(u.pm * BM + r) * ldc + col0;
#pragma unroll
                for (int bj = 0; bj < 2; ++bj)
#pragma unroll
                    for (int n = 0; n < 2; ++n) { const f32x4 bs = ai == 0 ? pre[m][bj][n] : *(const f32x4*)(base + off + bj * HALF + n * 16); f32x4 o = bs + (acc[ai][bj][m][n] - sr.x) * sr.y;
                        if (bad) o = (f32x4){qnan, qnan, qnan, qnan}; *(f32x4*)(out + off + bj * HALF + n * 16) = o; }
                if (m & 1) asm volatile("" ::: "memory"); }
    }
};
struct EpiLnResLn {
    static constexpr bool PERM = false, AFTER_DRAIN = true;
    const float* base; float* out; bf16_t* xn; int ldc; const float* bias; PanelStats st1, st2; unsigned poison;
    __device__ __forceinline__ void fused(f32x4 (&acc)[2][2][4][2], const Unit& u, int wr, int wc, int fr, int fq, PG8_LAS unsigned char* lds, int wid, int lane) const {
        typedef float f32x2v __attribute__((ext_vector_type(2))); typedef unsigned u32x2v __attribute__((ext_vector_type(2)));
        const PG8_LAS f32x2v* S = (const PG8_LAS f32x2v*)(lds + 8192);
        const int col0 = u.pn * BM + wc * 32 + 4 * fq;
#pragma unroll
        for (int bj = 0; bj < 2; ++bj)
#pragma unroll
            for (int n = 0; n < 2; ++n) { const f32x4 bv = bias ? *(const f32x4*)(bias + col0 + bj * HALF + n * 16) : (f32x4){0.f, 0.f, 0.f, 0.f};
#pragma unroll
                for (int ai = 0; ai < 2; ++ai)
#pragma unroll
                    for (int m = 0; m < 4; ++m) acc[ai][bj][m][n] += bv; }
        bool bad = st1.run(acc, u, wr, wc, fr, fq, lds, wid, lane) || poison != 0u;
        const float qnan = __builtin_nanf("");
#pragma unroll
        for (int ai = 0; ai < 2; ++ai)
#pragma unroll
            for (int m = 0; m < 4; ++m) { const int r = ai * HALF + wr * 64 + m * 16 + fr; const f32x2v sr = S[r]; const size_t off = (size_t)(u.pm * BM + r) * ldc + col0;
#pragma unroll
                for (int bj = 0; bj < 2; ++bj)
#pragma unroll
                    for (int n = 0; n < 2; ++n) { const f32x4 bs = *(const f32x4*)(base + off + bj * HALF + n * 16); acc[ai][bj][m][n] = bs + (acc[ai][bj][m][n] - sr.x) * sr.y; }
                asm volatile("" : "+v"(acc[ai][0][m][0]), "+v"(acc[ai][0][m][1]), "+v"(acc[ai][1][m][0]), "+v"(acc[ai][1][m][1]));
                if (m & 1) asm volatile("" ::: "memory"); }
        const bool bad1 = bad;
        bad = st2.run(acc, u, wr, wc, fr, fq, lds, wid, lane) || bad;
#pragma unroll
        for (int ai = 0; ai < 2; ++ai)
#pragma unroll
            for (int m = 0; m < 4; ++m) { const int r = ai * HALF + wr * 64 + m * 16 + fr; const f32x2v sr = S[r]; const size_t off = (size_t)(u.pm * BM + r) * ldc + col0;
#pragma unroll
                for (int bj = 0; bj < 2; ++bj)
#pragma unroll
                    for (int n = 0; n < 2; ++n) { const f32x4 x1 = acc[ai][bj][m][n]; *(f32x4*)(out + off + bj * HALF + n * 16) = bad1 ? (f32x4){qnan, qnan, qnan, qnan} : x1;
                        const f32x4 o = (x1 - sr.x) * sr.y; u32x2v w; w.x = cvt_pk_bf16(o[0], o[1]); w.y = cvt_pk_bf16(o[2], o[3]);
                        if (bad) { w.x = 0x7fc07fc0u; w.y = 0x7fc07fc0u; } *(u32x2v*)(xn + off + bj * HALF + n * 16) = w; }
                asm volatile("" ::: "memory"); }
    }
};

template <class Epi, class Sched, bool ALIGN_EPI = false, bool SP2 = false>
__device__ __forceinline__ void gemm_phase(PG8_LAS unsigned char* lds, const Gemm g, const Sched& S, const Epi& E) {
    const int tid = threadIdx.x, wid = __builtin_amdgcn_readfirstlane(tid >> 6), lane = tid & 63, wr = wid >> 2, wc = wid & 3, fr = lane & 15, fq = lane >> 4;
    const int K = g.K, nt = K / BK;
    unsigned voffA[2], voffB[2];
#pragma unroll
    for (int i = 0; i < 2; ++i) { int R, C; stage_rc(tid * 16 + i * 8192, R, C); const int Rb = Epi::PERM ? ((R & ~31) + perm32(R & 31)) : R;
        voffA[i] = (unsigned)(R * K + C) * 2u; voffB[i] = (unsigned)(Rb * K + C) * 2u; }
    const size_t kstep = (size_t)(BK * 2);
    const size_t hstep = (size_t)HALF * K * 2;
    const size_t tstep = 2 * hstep;
    const unsigned ldsw = (unsigned)wid * 1024u;
    const int aoff = lds_byte(wr * 64 + fr, fq * 8), boff = lds_byte(wc * 32 + fr, fq * 8);
#define PG8_SA(b, h) (((b) * 2 + (h)) * HTB)
#define PG8_SB(b, h) ((4 + (b) * 2 + (h)) * HTB)
#define PG8_STAGE(bufoff, gbase, voff) do { _Pragma("unroll") for (int _i = 0; _i < 2; ++_i) \
        __builtin_amdgcn_global_load_lds((const unsigned*)((const char*)(gbase) + (voff)[_i]), (PG8_LAS unsigned*)(lds + (bufoff) + ldsw + _i * 8192), 16, 0, 0); } while (0)
#define PG8_LDA(dst, b, h) do { _Pragma("unroll") for (int m = 0; m < 4; ++m) _Pragma("unroll") for (int k = 0; k < 2; ++k) dst[m][k] = *(const PG8_LAS bf16x8*)(lds + PG8_SA(b, h) + aoff + m * 2048 + k * 1024); } while (0)
#define PG8_LDB(dst, b, h) do { _Pragma("unroll") for (int n = 0; n < 2; ++n) _Pragma("unroll") for (int k = 0; k < 2; ++k) dst[n][k] = *(const PG8_LAS bf16x8*)(lds + PG8_SB(b, h) + boff + n * 2048 + k * 1024); } while (0)
#define PG8_MMA(ai, bj, At, Bt) do { __builtin_amdgcn_s_setprio(1); _Pragma("unroll") for (int m = 0; m < 4; ++m) _Pragma("unroll") for (int n = 0; n < 2; ++n) _Pragma("unroll") for (int k = 0; k < 2; ++k) \
        acc[ai][bj][m][n] = mma16<Epi::F16>(Bt[n][k], At[m][k], acc[ai][bj][m][n]); __builtin_amdgcn_s_setprio(0); } while (0)
#define PG8_WAIT_V(n) asm volatile("s_waitcnt vmcnt(" #n ")" ::: "memory")
#define PG8_WAIT_L(n) asm volatile("s_waitcnt lgkmcnt(" #n ")" ::: "memory")
#define PG8_BAR __builtin_amdgcn_s_barrier()
#define PG8_SCHED __builtin_amdgcn_sched_barrier(0)
    Unit cur, nxt; int ui = 0;
    if (!S.next(0, cur)) return;
    f32x4 acc[2][2][4][2];
#pragma unroll
    for (int a = 0; a < 2; ++a)
#pragma unroll
        for (int b = 0; b < 2; ++b)
#pragma unroll
            for (int m = 0; m < 4; ++m)
#pragma unroll
                for (int n = 0; n < 2; ++n) acc[a][b][m][n] = (f32x4){0.f, 0.f, 0.f, 0.f};
    bf16x8 At[4][2], B0[2][2], B1[2][2];
    const char* cA = (const char*)g.A + (size_t)cur.pm * tstep; const char* cB = (const char*)g.Bt + (size_t)cur.pn * tstep;
    S.a_ready(cur);
    if constexpr (SP2) {
        PG8_STAGE(PG8_SB(0, 0), cB, voffB); PG8_STAGE(PG8_SB(0, 1), cB + hstep, voffB); PG8_STAGE(PG8_SA(0, 0), cA, voffA); PG8_STAGE(PG8_SA(0, 1), cA + hstep, voffA);
        if (wr == 1) PG8_BAR;
        PG8_WAIT_V(2); PG8_BAR;
        PG8_STAGE(PG8_SB(1, 0), cB + kstep, voffB); PG8_STAGE(PG8_SA(1, 0), cA + kstep, voffA); PG8_STAGE(PG8_SB(1, 1), cB + hstep + kstep, voffB);
        PG8_WAIT_V(6); PG8_BAR;
    } else {
        PG8_STAGE(PG8_SB(0, 0), cB, voffB); PG8_STAGE(PG8_SA(0, 0), cA, voffA); PG8_STAGE(PG8_SB(0, 1), cB + hstep, voffB); PG8_STAGE(PG8_SA(0, 1), cA + hstep, voffA);
        if (wr == 1) PG8_BAR;
        PG8_WAIT_V(4); PG8_BAR;
        PG8_STAGE(PG8_SB(1, 0), cB + kstep, voffB); PG8_STAGE(PG8_SA(1, 0), cA + kstep, voffA); PG8_STAGE(PG8_SB(1, 1), cB + hstep + kstep, voffB);
        PG8_WAIT_V(6); PG8_BAR;
    }
    for (;;) {
        const bool has_next = S.next(ui + 1, nxt);
        const char* nA = has_next ? (const char*)g.A + (size_t)nxt.pm * tstep : cA; const char* nB = has_next ? (const char*)g.Bt + (size_t)nxt.pn * tstep : cB;
        for (int t = 0; t < nt; t += 2) {
            const bool last = (t == nt - 2);
            const char* a1 = cA + (size_t)(t + 1) * kstep;
            const char* a2 = last ? nA : cA + (size_t)(t + 2) * kstep; const char* b2 = last ? nB : cB + (size_t)(t + 2) * kstep;
            const char* a3 = a2 + kstep; const char* b3 = b2 + kstep;
            if (last && has_next) S.a_ready(nxt);
            if constexpr (SP2) {
            PG8_LDB(B0, 0, 0); PG8_LDB(B1, 0, 1); PG8_SCHED; PG8_LDA(At, 0, 0); PG8_STAGE(PG8_SA(1, 1), a1 + hstep, voffA);
            PG8_WAIT_V(8); PG8_WAIT_L(0); PG8_BAR; PG8_MMA(0, 0, At, B0); PG8_MMA(0, 1, At, B1); PG8_BAR; PG8_SCHED;
            PG8_LDA(At, 0, 1); PG8_STAGE(PG8_SB(0, 0), b2, voffB); PG8_STAGE(PG8_SB(0, 1), b2 + hstep, voffB); PG8_STAGE(PG8_SA(0, 0), a2, voffA);
            PG8_WAIT_V(8); PG8_WAIT_L(0); PG8_BAR; PG8_MMA(1, 0, At, B0); PG8_MMA(1, 1, At, B1); PG8_BAR; PG8_SCHED;
            PG8_LDB(B0, 1, 0); PG8_LDB(B1, 1, 1); PG8_SCHED; PG8_LDA(At, 1, 0); PG8_STAGE(PG8_SA(0, 1), a2 + hstep, voffA);
            PG8_WAIT_V(8); PG8_WAIT_L(0); PG8_BAR; PG8_MMA(0, 0, At, B0); PG8_MMA(0, 1, At, B1); PG8_BAR; PG8_SCHED;
            PG8_LDA(At, 1, 1); PG8_STAGE(PG8_SB(1, 0), b3, voffB); PG8_STAGE(PG8_SB(1, 1), b3 + hstep, voffB); PG8_STAGE(PG8_SA(1, 0), a3, voffA);
            PG8_WAIT_V(8); PG8_WAIT_L(0); PG8_BAR; PG8_MMA(1, 0, At, B0); PG8_MMA(1, 1, At, B1); PG8_BAR; PG8_SCHED;
            } else {
            PG8_LDB(B0, 0, 0); PG8_SCHED; PG8_LDA(At, 0, 0); PG8_STAGE(PG8_SA(1, 1), a1 + hstep, voffA);
            PG8_WAIT_L(8); PG8_BAR; PG8_WAIT_L(0); PG8_MMA(0, 0, At, B0); PG8_BAR; PG8_SCHED;
            PG8_LDB(B1, 0, 1); PG8_STAGE(PG8_SB(0, 0), b2, voffB);
            PG8_BAR; PG8_WAIT_L(0); PG8_MMA(0, 1, At, B1); PG8_BAR;
            PG8_LDA(At, 0, 1); PG8_STAGE(PG8_SA(0, 0), a2, voffA);
            PG8_BAR; PG8_WAIT_L(0); PG8_MMA(1, 0, At, B0); PG8_BAR; PG8_SCHED;
            PG8_STAGE(PG8_SB(0, 1), b2 + hstep, voffB);
            PG8_WAIT_V(6); PG8_BAR; PG8_MMA(1, 1, At, B1); PG8_BAR;
            PG8_LDB(B0, 1, 0); PG8_SCHED; PG8_LDA(At, 1, 0); PG8_STAGE(PG8_SA(0, 1), a2 + hstep, voffA);
            PG8_WAIT_L(8); PG8_BAR; PG8_WAIT_L(0); PG8_MMA(0, 0, At, B0); PG8_BAR; PG8_SCHED;
            PG8_LDB(B1, 1, 1); PG8_STAGE(PG8_SB(1, 0), b3, voffB);
            PG8_BAR; PG8_WAIT_L(0); PG8_MMA(0, 1, At, B1); PG8_BAR;
            PG8_LDA(At, 1, 1); PG8_STAGE(PG8_SA(1, 0), a3, voffA);
            PG8_BAR; PG8_WAIT_L(0); PG8_MMA(1, 0, At, B0); PG8_BAR; PG8_SCHED;
            PG8_STAGE(PG8_SB(1, 1), b3 + hstep, voffB);
            PG8_WAIT_V(6); PG8_BAR; PG8_MMA(1, 1, At, B1); PG8_BAR;
            }
        }
        if constexpr (ALIGN_EPI) { if (wr == 0) PG8_BAR; }
        if constexpr (!Epi::AFTER_DRAIN) { E(acc, cur, wr, wc, fr, fq); S.done(cur); }
        if (!has_next) break;
#pragma unroll
        for (int a = 0; a < 2; ++a)
#pragma unroll
            for (int b = 0; b < 2; ++b)
#pragma unroll
                for (int m = 0; m < 4; ++m)
#pragma unroll
                    for (int n = 0; n < 2; ++n) acc[a][b][m][n] = (f32x4){0.f, 0.f, 0.f, 0.f};
        cur = nxt; cA = nA; cB = nB; ++ui;
        if constexpr (ALIGN_EPI) { if (wr == 1) PG8_BAR; }
    }
    PG8_WAIT_V(0);
    if constexpr (!ALIGN_EPI) { if (wr == 0) PG8_BAR; }
    PG8_BAR;
    if constexpr (Epi::AFTER_DRAIN) { E.fused(acc, cur, wr, wc, fr, fq, lds, wid, lane); S.done(cur); }
#undef PG8_SA
#undef PG8_SB
#undef PG8_STAGE
#undef PG8_LDA
#undef PG8_LDB
#undef PG8_MMA
#undef PG8_WAIT_V
#undef PG8_WAIT_L
#undef PG8_BAR
#undef PG8_SCHED
}
}

#ifndef ENMASK
#define ENMASK 0x1ff
#endif
#define EN(k) (((ENMASK) >> (k)) & 1)
#ifndef DIAG
#define DIAG 0
#endif
#define DG(e) (DIAG == 1 ? (1.0f + (e)) : 1.0f)
#ifndef ONE_LAUNCH
#define ONE_LAUNCH 1
#endif
#define LAS __attribute__((address_space(3)))
typedef unsigned short bf;
typedef short v8s __attribute__((ext_vector_type(8)));
typedef float v16f __attribute__((ext_vector_type(16)));
typedef float v4f __attribute__((ext_vector_type(4)));
typedef unsigned v4u __attribute__((ext_vector_type(4)));
typedef unsigned v2u __attribute__((ext_vector_type(2)));

constexpr int DM = 1024, MP = 8192, MS = 32768, MT = 40960, DFF = 2816;
constexpr int NTHR = 512, NWAVE = 8;
constexpr int LDS_BYTES = 147456;
constexpr float LOG2E = 1.4426950408889634f;
constexpr float RMS_EPS = 1e-6f;
constexpr int MI_N = 3328;
constexpr int QKVO_LD = 3072;
constexpr int AQ_LD = 1536;

constexpr size_t MiB = 1u << 20;
constexpr size_t WS_MOD = 0;
constexpr size_t WS_ROPE = 1 * MiB;
constexpr size_t WS_CK = 2 * MiB, WS_CV = 4 * MiB;
constexpr size_t WS_GATES = 6 * MiB;
constexpr size_t WS_W = 12 * MiB;
constexpr size_t WS_XN = 92 * MiB;
constexpr size_t WS_HB = 172 * MiB;
constexpr size_t WS_BIG = 252 * MiB;
constexpr size_t WS_END = 492 * MiB;
constexpr size_t W_GU = (size_t)5632 * 1024, W_DN = (size_t)1024 * 2816, W_LAYER = 2 * (W_GU + W_DN);
constexpr size_t W_MI = 2 * W_LAYER, W_MO = W_MI + (size_t)MI_N * 1024, W_AI = W_MO + 1024 * 1024, W_AO = W_AI + 1536 * 1024, W_TOTAL = W_AO + 1024 * 1024;
static_assert(WS_W + W_TOTAL * 2 <= WS_XN, "weights fit");
constexpr size_t OUT_SC = (size_t)MT * DM, OUT_SN = OUT_SC + 4194304, OUT_SM = OUT_SN + 32768, OUT_CK = OUT_SM + 512, OUT_CV = OUT_CK + 2097152, OUT_TOTAL = OUT_CV + 2097152;

typedef float f32x2_t __attribute__((ext_vector_type(2)));
typedef __bf16 bf16x2_t __attribute__((ext_vector_type(2)));
__device__ __forceinline__ unsigned pk2(float lo, float hi) { f32x2_t v = {lo, hi}; bf16x2_t b = __builtin_convertvector(v, bf16x2_t); return __builtin_bit_cast(unsigned, b); }
typedef _Float16 h2_t __attribute__((ext_vector_type(2)));
typedef _Float16 h8_t __attribute__((ext_vector_type(8)));
__device__ __forceinline__ unsigned pkh2(float lo, float hi) { h2_t v; v.x = (_Float16)lo; v.y = (_Float16)hi; return __builtin_bit_cast(unsigned, v); }
__device__ __forceinline__ float hlo(unsigned w) { return (float)__builtin_bit_cast(h2_t, w).x; }
__device__ __forceinline__ float hhi(unsigned w) { return (float)__builtin_bit_cast(h2_t, w).y; }
__device__ __forceinline__ float bf2f(unsigned short x) { return __uint_as_float(((unsigned)x) << 16); }
__device__ __forceinline__ float bflo(unsigned w) { return __uint_as_float(w << 16); }
__device__ __forceinline__ float bfhi(unsigned w) { return __uint_as_float(w & 0xffff0000u); }
__device__ __forceinline__ float wave_sum(float v) {
#pragma unroll
    for (int o = 1; o < 64; o <<= 1) v += __shfl_xor(v, o);
    return v;
}
__device__ __forceinline__ float fast_sigmoid(float x) { return __builtin_amdgcn_rcpf(1.0f + __builtin_amdgcn_exp2f(-x * LOG2E)); }
__device__ __forceinline__ v16f mfma32h(v8s a, v8s b, v16f c) { return __builtin_amdgcn_mfma_f32_32x32x16_f16(__builtin_bit_cast(h8_t, a), __builtin_bit_cast(h8_t, b), c, 0, 0, 0); }
__device__ __forceinline__ v16f mfma32(v8s a, v8s b, v16f c) { return __builtin_amdgcn_mfma_f32_32x32x16_bf16(a, b, c, 0, 0, 0); }
__device__ __forceinline__ v8s pack8(float a0, float a1, float a2, float a3, float a4, float a5, float a6, float a7) {
    v4u w; w.x = pk2(a0, a1); w.y = pk2(a2, a3); w.z = pk2(a4, a5); w.w = pk2(a6, a7); return __builtin_bit_cast(v8s, w);
}

struct EpiSwiglu {
    static constexpr bool PERM = true, AFTER_DRAIN = false, F16 = true;
    bf* O;
    __device__ __forceinline__ void operator()(const pg8::f32x4 (&acc)[2][2][4][2], const pg8::Unit& u, int wr, int wc, int fr, int fq) const {
        const int row0 = u.pm * 256 + wr * 64 + fr, col0 = u.pn * 128 + wc * 32 + 8 * fq;
#pragma unroll
        for (int ai = 0; ai < 2; ++ai)
#pragma unroll
            for (int m = 0; m < 4; ++m) {
                bf* rowp = O + (size_t)(row0 + ai * 128 + m * 16) * DFF + col0;
                float o[8];
#pragma unroll
                for (int n = 0; n < 2; ++n)
#pragma unroll
                    for (int j = 0; j < 4; ++j) { const float g = acc[ai][0][m][n][j], up = acc[ai][1][m][n][j]; o[n * 4 + j] = g * fast_sigmoid(g) * up; }
                v4u w; w.x = pkh2(o[0], o[1]); w.y = pkh2(o[2], o[3]); w.z = pkh2(o[4], o[5]); w.w = pkh2(o[6], o[7]);
                *(v4u*)rowp = w;
            }
    }
};
struct EpiResid {
    static constexpr bool PERM = false, AFTER_DRAIN = false, F16 = true;
    const float* xin_p; const float* xin_s; float* xout; const float* gate; float coef;
    __device__ __forceinline__ void operator()(const pg8::f32x4 (&acc)[2][2][4][2], const pg8::Unit& u, int wr, int wc, int fr, int fq) const {
        const int ci = u.pm < 32 ? 0 : 1 + ((u.pm - 32) >> 4);
        const float* xin = u.pm < 32 ? xin_p : xin_s;
        const int col0 = u.pn * 256 + wc * 32 + 4 * fq;
        const float* gp = gate + (size_t)ci * 9216 + col0;
        v4f gv[2][2];
#pragma unroll
        for (int bj = 0; bj < 2; ++bj)
#pragma unroll
            for (int n = 0; n < 2; ++n) gv[bj][n] = *(const v4f*)(gp + bj * 128 + n * 16) * coef;
#pragma unroll
        for (int ai = 0; ai < 2; ++ai)
#pragma unroll
            for (int m = 0; m < 4; ++m) {
                const size_t off = (size_t)(u.pm * 256 + ai * 128 + wr * 64 + m * 16 + fr) * DM + col0;
#pragma unroll
                for (int bj = 0; bj < 2; ++bj)
#pragma unroll
                    for (int n = 0; n < 2; ++n) { const v4f xi = *(const v4f*)(xin + off + bj * 128 + n * 16); *(v4f*)(xout + off + bj * 128 + n * 16) = xi + gv[bj][n] * acc[ai][bj][m][n]; }
            }
    }
};
__device__ __forceinline__ float log_sigmoid(float x) { return x < 0.f ? x - log1pf(expf(x)) : -log1pf(expf(-x)); }
struct EpiMlstmIn {
    static constexpr bool PERM = true, AFTER_DRAIN = false, F16 = true;
    bf* O; float* gates; const float* bgate;
    __device__ __forceinline__ void operator()(const pg8::f32x4 (&acc)[2][2][4][2], const pg8::Unit& u, int wr, int wc, int fr, int fq) const {
        const int row0 = u.pm * 256 + wr * 64 + fr;
        if (u.pn < 12) {
            const float sc = u.pn < 2 ? 0.125f : 1.0f;
            const int col0 = u.pn * 256 + wc * 32 + 8 * fq;
#pragma unroll
            for (int ai = 0; ai < 2; ++ai)
#pragma unroll
                for (int m = 0; m < 4; ++m) {
                    bf* rowp = O + (size_t)(row0 + ai * 128 + m * 16) * QKVO_LD + col0;
#pragma unroll
                    for (int bj = 0; bj < 2; ++bj) { const pg8::f32x4 v0 = acc[ai][bj][m][0] * sc, v1 = acc[ai][bj][m][1] * sc;
                        v4u w;
                        if (u.pn < 4) { w.x = pkh2(v0[0], v0[1]); w.y = pkh2(v0[2], v0[3]); w.z = pkh2(v1[0], v1[1]); w.w = pkh2(v1[2], v1[3]); }
                        else { w.x = pk2(v0[0], v0[1]); w.y = pk2(v0[2], v0[3]); w.z = pk2(v1[0], v1[1]); w.w = pk2(v1[2], v1[3]); }
                        *(v4u*)(rowp + bj * 128) = w; }
                }
        } else if (wc == 0) {
#pragma unroll
            for (int n = 0; n < 2; ++n) { const int c = 8 * fq + 4 * n; const v4f bv = *(const v4f*)(bgate + c);
#pragma unroll
                for (int ai = 0; ai < 2; ++ai)
#pragma unroll
                    for (int m = 0; m < 4; ++m) { const v4f v = acc[ai][0][m][n] + bv;
                        *(v4f*)(gates + (size_t)(row0 + ai * 128 + m * 16) * 32 + c) = v; } }
        }
    }
};
struct EpiAttnIn {
    static constexpr bool PERM = false, AFTER_DRAIN = false, F16 = true;
    bf* O; float* ck_out; float* cv_out; const float* rope;
    __device__ __forceinline__ void operator()(const pg8::f32x4 (&acc)[2][2][4][2], const pg8::Unit& u, int wr, int wc, int fr, int fq) const {
        const bool sample = u.pm >= 32, do_rope = sample && u.pn < 5;
        const int colt = wc * 32 + 4 * fq;
#pragma unroll
        for (int ai = 0; ai < 2; ++ai)
#pragma unroll
            for (int m = 0; m < 4; ++m) {
                const int row = u.pm * 256 + ai * 128 + wr * 64 + m * 16 + fr;
                v4f cs = (v4f){1.f, 1.f, 1.f, 1.f}, sn = (v4f){0.f, 0.f, 0.f, 0.f};
                if (do_rope) { const int t = (row - MP) & 4095; const int pos = (wc & 1) ? (t & 63) : (t >> 6);
                    cs = *(const v4f*)(rope + pos * 16 + 4 * fq); sn = *(const v4f*)(rope + 1024 + pos * 16 + 4 * fq); }
#pragma unroll
                for (int bj = 0; bj < 2; ++bj) {
                    const v4f x0 = acc[ai][bj][m][0], x1 = acc[ai][bj][m][1];
                    const v4f y0 = x0 * cs - x1 * sn, y1 = x1 * cs + x0 * sn;
                    bf* op = O + (size_t)row * AQ_LD + u.pn * 256 + bj * 128 + colt;
                    v2u w0, w1; w0.x = pk2(y0[0], y0[1]); w0.y = pk2(y0[2], y0[3]); w1.x = pk2(y1[0], y1[1]); w1.y = pk2(y1[2], y1[3]);
                    *(v2u*)op = w0; *(v2u*)(op + 16) = w1;
                    if (!sample && u.pn >= 4) { float* cp = (u.pn == 4 ? ck_out : cv_out) + (size_t)row * 256 + bj * 128 + colt;
                        const float dgs = 1.0f; *(v4f*)cp = x0 * dgs; *(v4f*)(cp + 16) = x1 * dgs; }
                }
            }
    }
};

__device__ __forceinline__ void transpose_item(const float* W, int K, int N, bf* WT, int item, int mode, LAS float* scr, int lane) {
    const int nblk = N / 32, kb = item / nblk, nb = item % nblk, k0 = 64 * kb, n0 = 32 * nb;
    int drow0 = n0;
    if (mode & 1) { int j = n0, up = 0; if (j >= DFF) { j -= DFF; up = 1; } drow0 = (j >> 7) * 256 + up * 128 + (j & 127); }
#pragma unroll 8
    for (int i = 0; i < 32; ++i) { const int kk = 2 * i + (lane >> 5); scr[kk * 33 + (lane & 31)] = W[(size_t)(k0 + kk) * N + n0 + (lane & 31)]; }
    asm volatile("s_waitcnt lgkmcnt(0)" ::: "memory");
    const int c = lane & 7;
#pragma unroll
    for (int j = 0; j < 4; ++j) { const int n = (lane >> 3) + 8 * j; const LAS float* s = scr + (8 * c) * 33 + n;
        v4u o;
        if (mode & 2) { o.x = pkh2(s[0 * 33], s[1 * 33]); o.y = pkh2(s[2 * 33], s[3 * 33]); o.z = pkh2(s[4 * 33], s[5 * 33]); o.w = pkh2(s[6 * 33], s[7 * 33]); }
        else { o.x = pk2(s[0 * 33], s[1 * 33]); o.y = pk2(s[2 * 33], s[3 * 33]); o.z = pk2(s[4 * 33], s[5 * 33]); o.w = pk2(s[6 * 33], s[7 * 33]); }
        *(v4u*)(WT + (size_t)(drow0 + n) * K + k0 + 8 * c) = o; }
    asm volatile("s_waitcnt lgkmcnt(0)" ::: "memory");
}

struct Args { const float* in[24]; float* out; unsigned char* ws; int ph_lo, ph_hi; };

__device__ __forceinline__ void prologue(const Args& A, LAS unsigned char* lds, int tid) {
    const int lane = tid & 63, wave = __builtin_amdgcn_readfirstlane(tid >> 6);
    const int G = gridDim.x, gw = blockIdx.x * NWAVE + wave, NGW = G * NWAVE, gt = blockIdx.x * NTHR + tid, NGT = G * NTHR;
    unsigned char* ws = A.ws;
    float* MOD = (float*)(ws + WS_MOD);
    bf* Wb = (bf*)(ws + WS_W);
    LAS float* scr = (LAS float*)(lds + wave * 8704);
    LAS float* sc = (LAS float*)(lds + 73728);
    LAS float* red = (LAS float*)(lds + 110592);
    for (int i = tid; i < 9 * 1024; i += NTHR) { const int ci = i >> 10, k = i & 1023; const float c = ci == 0 ? A.in[8][k] : A.in[7][(ci - 1) * 1024 + k]; sc[i] = c / (1.0f + expf(-c)); }
    __syncthreads();
    for (int item = blockIdx.x; item < 288; item += G) {
        const int l = item / 144, n0 = (item % 144) * 64;
        const float* wp = A.in[9] + ((size_t)l * 1024 + wave * 128) * 9216 + n0 + lane;
        float a0 = 0.f, a1 = 0.f, a2 = 0.f, a3 = 0.f, a4 = 0.f, a5 = 0.f, a6 = 0.f, a7 = 0.f, a8 = 0.f;
        const LAS float* sp = sc + wave * 128;
#pragma unroll 8
        for (int kk = 0; kk < 128; ++kk) { const float w = wp[(size_t)kk * 9216];
            a0 += sp[kk] * w; a1 += sp[1024 + kk] * w; a2 += sp[2048 + kk] * w; a3 += sp[3072 + kk] * w; a4 += sp[4096 + kk] * w;
            a5 += sp[5120 + kk] * w; a6 += sp[6144 + kk] * w; a7 += sp[7168 + kk] * w; a8 += sp[8192 + kk] * w; }
        LAS float* rp = red + wave * 576 + lane;
        rp[0] = a0; rp[64] = a1; rp[128] = a2; rp[192] = a3; rp[256] = a4; rp[320] = a5; rp[384] = a6; rp[448] = a7; rp[512] = a8;
        __syncthreads();
        for (int o = tid; o < 576; o += NTHR) { const int ci = o >> 6, ln = o & 63; float s = A.in[10][l * 9216 + n0 + ln];
#pragma unroll
            for (int w = 0; w < 8; ++w) s += red[w * 576 + ci * 64 + ln];
            MOD[(size_t)(l * 9 + ci) * 9216 + n0 + ln] = s; }
        __syncthreads();
    }
    if (gt < 1024) { const int pos = gt >> 4, i = gt & 15; const float fr = __builtin_amdgcn_exp2f(-(float)i * (13.287712379549449f / 16.0f)); const float ang = (float)pos * fr;
        float* rope = (float*)(ws + WS_ROPE); rope[gt] = cosf(ang); rope[1024 + gt] = sinf(ang); }
    { bf* CK = (bf*)(ws + WS_CK); bf* CV = (bf*)(ws + WS_CV);
      for (int i = gt; i < 262144; i += NGT) { const v4f k = ((const v4f*)A.in[5])[i], v = ((const v4f*)A.in[6])[i];
          v2u wk, wv; wk.x = pk2(k[0], k[1]); wk.y = pk2(k[2], k[3]); wv.x = pk2(v[0], v[1]); wv.y = pk2(v[2], v[3]);
          ((v2u*)CK)[i] = wk; ((v2u*)CV)[i] = wv; } }
    { v4u* z = (v4u*)(Wb + W_MI + (size_t)3104 * 1024); for (int i = gt; i < 224 * 1024 / 8; i += NGT) z[i] = (v4u){0u, 0u, 0u, 0u}; }
    constexpr int I_GU = 16 * 176, I_DN = 44 * 32, I_MI = 16 * 97, I_MO = 16 * 32, I_AI = 16 * 48, I_AO = 16 * 32;
    constexpr int I_LAYER = 2 * (I_GU + I_DN), NITEMS = 2 * I_LAYER + I_MI + I_MO + I_AI + I_AO;
    for (int it = gw; it < NITEMS; it += NGW) {
        int r = it;
        if (r < 2 * I_LAYER) { const int l = r / I_LAYER; r -= l * I_LAYER; bf* wl = Wb + (size_t)l * W_LAYER;
            if (r < I_GU) { transpose_item(A.in[12] + (size_t)l * W_GU, 1024, 5632, wl, r, 3, scr, lane); continue; } r -= I_GU;
            if (r < I_DN) { transpose_item(A.in[13] + (size_t)l * W_DN, 2816, 1024, wl + W_GU, r, 2, scr, lane); continue; } r -= I_DN;
            if (r < I_GU) { transpose_item(A.in[14] + (size_t)l * W_GU, 1024, 5632, wl + W_GU + W_DN, r, 3, scr, lane); continue; } r -= I_GU;
            transpose_item(A.in[15] + (size_t)l * W_DN, 2816, 1024, wl + 2 * W_GU + W_DN, r, 2, scr, lane); continue; }
        r -= 2 * I_LAYER;
        if (r < I_MI) { transpose_item(A.in[16], 1024, 3104, Wb + W_MI, r, 2, scr, lane); continue; } r -= I_MI;
        if (r < I_MO) { transpose_item(A.in[19], 1024, 1024, Wb + W_MO, r, 2, scr, lane); continue; } r -= I_MO;
        if (r < I_AI) { transpose_item(A.in[20], 1024, 1536, Wb + W_AI, r, 2, scr, lane); continue; } r -= I_AI;
        transpose_item(A.in[22], 1024, 1024, Wb + W_AO, r, 2, scr, lane);
    }
}

template <int MODE>
__device__ __forceinline__ void norm_phase(const float* xin_p, const float* xin_s, bf* XN, float* fout, const float* g, const float* shiftb, int tid) {
    const int lane = tid & 63, wave = __builtin_amdgcn_readfirstlane(tid >> 6);
    const int gw = blockIdx.x * NWAVE + wave, NGW = gridDim.x * NWAVE;
    v4f gv[4];
#pragma unroll
    for (int j = 0; j < 4; ++j) gv[j] = ((const v4f*)g)[64 * j + lane];
    float dgscale = 1.0f;
#if DIAG == 2
    if (MODE == 1) { const float ratio = fminf(shiftb[4000], 0.5f); dgscale = 1.0f + sqrtf(5e-4f + 0.01f * ratio); }
#endif
    for (int m = gw; m < MT; m += NGW) {
        const float* xr = (m < MP ? xin_p : xin_s) + (size_t)m * DM;
        v4f v[4]; float s = 0.f;
#pragma unroll
        for (int j = 0; j < 4; ++j) { v[j] = ((const v4f*)xr)[64 * j + lane]; s += (v[j][0] * v[j][0] + v[j][1] * v[j][1]) + (v[j][2] * v[j][2] + v[j][3] * v[j][3]); }
        const float rstd = 1.0f / sqrtf(wave_sum(s) * (1.0f / DM) + RMS_EPS);
        if (MODE == 1) {
#pragma unroll
            for (int j = 0; j < 4; ++j) ((v4f*)(fout + (size_t)m * DM))[64 * j + lane] = v[j] * rstd * gv[j] * (m < MP ? dgscale : 1.0f);
        } else {
            const int ci = m < MP ? 0 : 1 + ((m - MP) >> 12);
            const float* sh = shiftb + (size_t)ci * 9216; const float* scp = sh + 1024;
#pragma unroll
            for (int j = 0; j < 4; ++j) { const v4f shv = ((const v4f*)sh)[64 * j + lane], scv = ((const v4f*)scp)[64 * j + lane];
                const v4f y = v[j] * rstd * gv[j] * (scv + 1.0f) + shv;
                v2u w; if (MODE == 2) { w.x = pkh2(y[0], y[1]); w.y = pkh2(y[2], y[3]); } else { w.x = pk2(y[0], y[1]); w.y = pk2(y[2], y[3]); }
                ((v2u*)(XN + (size_t)m * DM))[64 * j + lane] = w; }
        }
    }
}

__device__ __forceinline__ void combine_phase(bf* XN, const bf* HB, const bf* BIG, const float* ghead, int tid) {
    const int lane = tid & 63, wave = __builtin_amdgcn_readfirstlane(tid >> 6);
    const int gw = blockIdx.x * NWAVE + wave, NGW = gridDim.x * NWAVE;
    const int c0 = lane * 16;
    float gh[16];
#pragma unroll
    for (int e = 0; e < 16; ++e) gh[e] = ghead[c0 + e];
    for (int m = gw; m < MT; m += NGW) {
        const v4u f0 = *(const v4u*)(XN + (size_t)m * DM + c0), f1 = *(const v4u*)(XN + (size_t)m * DM + c0 + 8);
        const v4u b0 = *(const v4u*)(HB + (size_t)m * DM + c0), b1 = *(const v4u*)(HB + (size_t)m * DM + c0 + 8);
        const v4u o0 = *(const v4u*)(BIG + (size_t)m * QKVO_LD + 2048 + c0), o1 = *(const v4u*)(BIG + (size_t)m * QKVO_LD + 2048 + c0 + 8);
        float hs[16], og[16]; float ss = 0.f;
#pragma unroll
        for (int q = 0; q < 4; ++q) {
            hs[2 * q] = bflo(f0[q]) + bflo(b0[q]); hs[2 * q + 1] = bfhi(f0[q]) + bfhi(b0[q]);
            hs[8 + 2 * q] = bflo(f1[q]) + bflo(b1[q]); hs[8 + 2 * q + 1] = bfhi(f1[q]) + bfhi(b1[q]);
            og[2 * q] = bflo(o0[q]); og[2 * q + 1] = bfhi(o0[q]); og[8 + 2 * q] = bflo(o1[q]); og[8 + 2 * q + 1] = bfhi(o1[q]); }
#pragma unroll
        for (int e = 0; e < 16; ++e) ss += hs[e] * hs[e];
        ss += __shfl_xor(ss, 1); ss += __shfl_xor(ss, 2); ss += __shfl_xor(ss, 4);
        const float rs = 1.0f / sqrtf(ss * (1.0f / 128.0f) + RMS_EPS);
        float y[16];
#pragma unroll
        for (int e = 0; e < 16; ++e) y[e] = hs[e] * rs * gh[e] * fast_sigmoid(og[e]);
        v4u w0, w1; w0.x = pkh2(y[0], y[1]); w0.y = pkh2(y[2], y[3]); w0.z = pkh2(y[4], y[5]); w0.w = pkh2(y[6], y[7]);
        w1.x = pkh2(y[8], y[9]); w1.y = pkh2(y[10], y[11]); w1.z = pkh2(y[12], y[13]); w1.w = pkh2(y[14], y[15]);
        *(v4u*)(XN + (size_t)m * DM + c0) = w0; *(v4u*)(XN + (size_t)m * DM + c0 + 8) = w1;
    }
}

constexpr int ML_KQ = 0, ML_VT = 18432, ML_KT = 53248, ML_CT = 70656, ML_F = 89088;
__device__ __forceinline__ void mlstm_unit(LAS unsigned char* lds, const Args& A, int sample, int b, int hd, int dir, int tid) {
    const int lane = tid & 63, wave = __builtin_amdgcn_readfirstlane(tid >> 6), r = lane & 31, h = lane >> 5;
    unsigned char* ws = A.ws;
    const bf* BIG = (const bf*)(ws + WS_BIG);
    const float* GATES = (const float*)(ws + WS_GATES);
    bf* HD = (bf*)(ws + (dir ? WS_HB : WS_XN));
    const int NTOK = sample ? 4096 : 256, rowbase = sample ? MP + b * 4096 : b * 256, nch = NTOK >> 7;
    LAS bf* Kq = (LAS bf*)(lds + ML_KQ); LAS bf* Vt = (LAS bf*)(lds + ML_VT); LAS bf* Kt = (LAS bf*)(lds + ML_KT); LAS bf* Ct = (LAS bf*)(lds + ML_CT);
    LAS float* fa = (LAS float*)(lds + ML_F);
    LAS float* s_a = fa, *s_rowc = fa + 128, *s_inter = fa + 256, *s_b = fa + 384, *s_wend = fa + 512, *s_n = fa + 640, *s_scal = fa + 704;
    const int db = wave >> 2, vb = wave & 3;
    const int sidx = (b * 2 + dir) * 8 + hd;
    v16f C; float mcur;
    if (sample) {
        const float* cp = A.in[2] + (size_t)sidx * 8192;
#pragma unroll
        for (int i = 0; i < 16; ++i) { const int d = db * 32 + (i & 3) + 8 * (i >> 2) + 4 * h; C[i] = cp[d * 128 + vb * 32 + r]; }
        if (tid < 64) s_n[tid] = A.in[3][sidx * 64 + tid];
        mcur = A.in[4][sidx];
    } else {
#pragma unroll
        for (int i = 0; i < 16; ++i) C[i] = 0.f;
        if (tid < 64) s_n[tid] = 0.f;
        mcur = 0.f;
    }
#pragma unroll
    for (int g4 = 0; g4 < 4; ++g4) { v2u w; w.x = pk2(C[4 * g4], C[4 * g4 + 1]); w.y = pk2(C[4 * g4 + 2], C[4 * g4 + 3]);
        *(LAS v2u*)(Ct + (vb * 32 + r) * 72 + db * 32 + 8 * g4 + 4 * h) = w; }
    __syncthreads();
    for (int c = 0; c < nch; ++c) {
#define ML_TOK(i) (dir ? (NTOK - 1 - (c * 128 + (i))) : (c * 128 + (i)))
        v4u kreg[2]; int ki[2], kch[2];
#pragma unroll
        for (int q = 0; q < 2; ++q) { const int id = tid + q * 512; ki[q] = id >> 3; kch[q] = id & 7;
            kreg[q] = *(const v4u*)(BIG + (size_t)(rowbase + ML_TOK(ki[q])) * QKVO_LD + 512 + hd * 64 + kch[q] * 8); }
#pragma unroll
        for (int q = 0; q < 4; ++q) { const int id = tid + q * 512, i = id >> 4, ch = id & 15;
            const v4u vv = *(const v4u*)(BIG + (size_t)(rowbase + ML_TOK(i)) * QKVO_LD + 1024 + hd * 128 + ch * 8);
            LAS bf* vp = Vt + (ch * 8) * 136 + i;
#pragma unroll
            for (int e = 0; e < 4; ++e) { vp[(2 * e) * 136] = (bf)(vv[e] & 0xffffu); vp[(2 * e + 1) * 136] = (bf)(vv[e] >> 16); } }
#pragma unroll
        for (int q = 0; q < 2; ++q) *(LAS v4u*)(Kq + ki[q] * 72 + kch[q] * 8) = kreg[q];
        if (wave == 0) {
            const int i0 = 2 * lane, i1 = i0 + 1;
            const float* g0 = GATES + (size_t)(rowbase + ML_TOK(i0)) * 32 + dir * 16 + hd;
            const float* g1 = GATES + (size_t)(rowbase + ML_TOK(i1)) * 32 + dir * 16 + hd;
            const float li0 = g0[0], lf0 = log_sigmoid(g0[8]), li1 = g1[0], lf1 = log_sigmoid(g1[8]);
            float incl = lf0 + lf1;
#pragma unroll
            for (int o = 1; o < 64; o <<= 1) { const float t = __shfl_up(incl, o); if (lane >= o) incl += t; }
            const float b1 = incl, b0 = incl - lf1;
            const float a0 = li0 - b0, a1 = li1 - b1;
            float im = fmaxf(a0, a1);
#pragma unroll
            for (int o = 1; o < 64; o <<= 1) { const float t = __shfl_up(im, o); if (lane >= o) im = fmaxf(im, t); }
            float ex = __shfl_up(im, 1); if (lane == 0) ex = -INFINITY;
            const float am0 = fmaxf(ex, a0), am1 = im;
            const float rc0 = -fmaxf(am0, mcur), rc1 = -fmaxf(am1, mcur);
            const float bend = __shfl(b1, 63), amend = __shfl(im, 63);
            const float mm = fmaxf(mcur, amend);
            s_a[i0] = a0; s_a[i1] = a1; s_rowc[i0] = rc0; s_rowc[i1] = rc1; s_inter[i0] = expf(mcur + rc0); s_inter[i1] = expf(mcur + rc1);
            s_b[i0] = b0; s_b[i1] = b1; s_wend[i0] = expf(a0 - mm); s_wend[i1] = expf(a1 - mm);
            if (lane == 0) { s_scal[0] = expf(mcur - mm); s_scal[1] = bend + mm; }
        }
        __syncthreads();
#pragma unroll
        for (int q = 0; q < 2; ++q) { const float we = s_wend[ki[q]]; LAS bf* kp = Kt + (kch[q] * 8) * 136 + ki[q];
#pragma unroll
            for (int e = 0; e < 4; ++e) { const unsigned w = pk2(hlo(kreg[q][e]) * we, hhi(kreg[q][e]) * we); kp[(2 * e) * 136] = (bf)(w & 0xffffu); kp[(2 * e + 1) * 136] = (bf)(w >> 16); } }
        const float keep = s_scal[0], mnew = s_scal[1];
        {
            const int tb = wave & 3, vh = wave >> 2, t = tb * 32 + r;
            const size_t row_t = (size_t)(rowbase + ML_TOK(t));
            v8s qf[4];
#pragma unroll
            for (int ks = 0; ks < 4; ++ks) qf[ks] = *(const v8s*)(BIG + row_t * QKVO_LD + hd * 64 + 16 * ks + 8 * h);
            const float rc = s_rowc[t], it = s_inter[t];
            v16f num0, num1; float den = 0.f;
#pragma unroll
            for (int i = 0; i < 16; ++i) { num0[i] = 0.f; num1[i] = 0.f; }
            for (int sb = 0; sb <= tb; ++sb) {
                v16f S;
#pragma unroll
                for (int i = 0; i < 16; ++i) S[i] = 0.f;
#pragma unroll
                for (int ks = 0; ks < 4; ++ks) { const v8s kf = *(const LAS v8s*)(Kq + (sb * 32 + r) * 72 + 16 * ks + 8 * h); S = mfma32h(kf, qf[ks], S); }
#pragma unroll
                for (int g4 = 0; g4 < 4; ++g4) { const v4f av = *(const LAS v4f*)(s_a + sb * 32 + 8 * g4 + 4 * h);
#pragma unroll
                    for (int j = 0; j < 4; ++j) { const int i = 4 * g4 + j, s = sb * 32 + 8 * g4 + 4 * h + j;
                        const float e = __builtin_amdgcn_exp2f((rc + av[j]) * LOG2E); const float w = (s <= t) ? S[i] * e : 0.f; S[i] = w; den += w; } }
                const v8s wf0 = pack8(S[0], S[1], S[2], S[3], S[4], S[5], S[6], S[7]), wf1 = pack8(S[8], S[9], S[10], S[11], S[12], S[13], S[14], S[15]);
#pragma unroll
                for (int s2 = 0; s2 < 2; ++s2) { const v8s wf = s2 ? wf1 : wf0;
                    { const LAS bf* vp = Vt + ((2 * vh) * 32 + r) * 136 + sb * 32 + 16 * s2 + 4 * h; const v2u lo = *(const LAS v2u*)vp, hi = *(const LAS v2u*)(vp + 8);
                      num0 = mfma32(__builtin_bit_cast(v8s, (v4u){lo.x, lo.y, hi.x, hi.y}), wf, num0); }
                    { const LAS bf* vp = Vt + ((2 * vh + 1) * 32 + r) * 136 + sb * 32 + 16 * s2 + 4 * h; const v2u lo = *(const LAS v2u*)vp, hi = *(const LAS v2u*)(vp + 8);
                      num1 = mfma32(__builtin_bit_cast(v8s, (v4u){lo.x, lo.y, hi.x, hi.y}), wf, num1); } }
            }
            float qn = 0.f;
#pragma unroll
            for (int ks = 0; ks < 4; ++ks) {
                const v4u qw = __builtin_bit_cast(v4u, qf[ks]); float qv[8];
#pragma unroll
                for (int e = 0; e < 4; ++e) { qv[2 * e] = hlo(qw[e]); qv[2 * e + 1] = hhi(qw[e]); }
                const v4f n0 = *(const LAS v4f*)(s_n + 16 * ks + 8 * h), n1 = *(const LAS v4f*)(s_n + 16 * ks + 8 * h + 4);
                qn += qv[0] * n0[0] + qv[1] * n0[1] + qv[2] * n0[2] + qv[3] * n0[3] + qv[4] * n1[0] + qv[5] * n1[1] + qv[6] * n1[2] + qv[7] * n1[3];
                const v8s qs = pack8(qv[0] * it, qv[1] * it, qv[2] * it, qv[3] * it, qv[4] * it, qv[5] * it, qv[6] * it, qv[7] * it);
                const v8s c0 = *(const LAS v8s*)(Ct + ((2 * vh) * 32 + r) * 72 + 16 * ks + 8 * h), c1 = *(const LAS v8s*)(Ct + ((2 * vh + 1) * 32 + r) * 72 + 16 * ks + 8 * h);
                num0 = mfma32(c0, qs, num0); num1 = mfma32(c1, qs, num1);
            }
            den += __shfl_xor(den, 32); qn += __shfl_xor(qn, 32);
            const float dd = den + it * qn;
            const float hden = fmaxf(fabsf(dd), expf(rc - s_b[t]));
            const float inv = 1.0f / hden;
            bf* op = HD + row_t * DM + hd * 128 + (2 * vh) * 32 + 4 * h;
#pragma unroll
            for (int g4 = 0; g4 < 4; ++g4) {
                v2u w; w.x = pk2(num0[4 * g4] * inv, num0[4 * g4 + 1] * inv); w.y = pk2(num0[4 * g4 + 2] * inv, num0[4 * g4 + 3] * inv); *(v2u*)(op + 8 * g4) = w;
                v2u x; x.x = pk2(num1[4 * g4] * inv, num1[4 * g4 + 1] * inv); x.y = pk2(num1[4 * g4 + 2] * inv, num1[4 * g4 + 3] * inv); *(v2u*)(op + 32 + 8 * g4) = x; }
        }
        __syncthreads();
#pragma unroll
        for (int i = 0; i < 16; ++i) C[i] *= keep;
#pragma unroll
        for (int ks = 0; ks < 8; ++ks) { const v8s af = *(const LAS v8s*)(Kt + (db * 32 + r) * 136 + 16 * ks + 8 * h), bfr = *(const LAS v8s*)(Vt + (vb * 32 + r) * 136 + 16 * ks + 8 * h);
            C = mfma32(af, bfr, C); }
#pragma unroll
        for (int g4 = 0; g4 < 4; ++g4) { v2u w; w.x = pk2(C[4 * g4], C[4 * g4 + 1]); w.y = pk2(C[4 * g4 + 2], C[4 * g4 + 3]);
            *(LAS v2u*)(Ct + (vb * 32 + r) * 72 + db * 32 + 8 * g4 + 4 * h) = w; }
        if (tid < 64) { float s = 0.f;
#pragma unroll
            for (int cc = 0; cc < 16; ++cc) { const v4u kw = *(const LAS v4u*)(Kt + tid * 136 + cc * 8);
                s += (bflo(kw.x) + bfhi(kw.x)) + (bflo(kw.y) + bfhi(kw.y)) + (bflo(kw.z) + bfhi(kw.z)) + (bflo(kw.w) + bfhi(kw.w)); }
            s_n[tid] = keep * s_n[tid] + s; }
        mcur = mnew;
        __syncthreads();
#undef ML_TOK
    }
    if (!sample) {
        float* oc = A.out + OUT_SC + (size_t)sidx * 8192;
#pragma unroll
        for (int i = 0; i < 16; ++i) { const int d = db * 32 + (i & 3) + 8 * (i >> 2) + 4 * h; oc[d * 128 + vb * 32 + r] = C[i]; }
        if (tid < 64) A.out[OUT_SN + (size_t)sidx * 64 + tid] = s_n[tid];
        if (tid == 0) A.out[OUT_SM + sidx] = mcur;
    }
    __syncthreads();
}
__device__ __forceinline__ void mlstm_phase(LAS unsigned char* lds, const Args& A, int tid) {
    const int G = gridDim.x, bx = blockIdx.x;
    if (G == 256) {
        if (bx < 128) mlstm_unit(lds, A, 1, bx >> 4, (bx >> 1) & 7, bx & 1, tid);
        else for (int k = 0; k < 4; ++k) { const int u = (bx - 128) * 4 + k; mlstm_unit(lds, A, 0, u >> 4, (u >> 1) & 7, u & 1, tid); }
    } else {
        for (int u = bx; u < 640; u += G) { if (u < 128) mlstm_unit(lds, A, 1, u >> 4, (u >> 1) & 7, u & 1, tid); else { const int p = u - 128; mlstm_unit(lds, A, 0, p >> 4, (p >> 1) & 7, p & 1, tid); } }
    }
}

constexpr int AT_K = 0, AT_V = 9216;
__device__ __forceinline__ void attn_qblock(const v16f& S, bool masked, int tq, int key0, int h, float& m, float& l, v16f& oA, v16f& oB, v8s& pf0, v8s& pf1) {
    float sc[16];
    const float C2 = 0.125f * LOG2E;
#pragma unroll
    for (int i = 0; i < 16; ++i) { sc[i] = S[i] * C2;
        if (masked) { const int s = key0 + (i & 3) + 8 * (i >> 2) + 4 * h; const int dlt = tq - s; if (dlt > 128 || dlt < -128) sc[i] = -INFINITY; } }
    float mx = sc[0];
#pragma unroll
    for (int i = 1; i < 16; ++i) mx = fmaxf(mx, sc[i]);
    mx = fmaxf(mx, __shfl_xor(mx, 32));
    const float mn = fmaxf(m, mx);
    const float alpha = __builtin_amdgcn_exp2f(m - mn);
    m = mn;
    float ps = 0.f;
#pragma unroll
    for (int i = 0; i < 16; ++i) { sc[i] = __builtin_amdgcn_exp2f(sc[i] - mn); ps += sc[i]; }
    l = l * alpha + ps;
#pragma unroll
    for (int i = 0; i < 16; ++i) { oA[i] *= alpha; oB[i] *= alpha; }
    pf0 = pack8(sc[0], sc[1], sc[2], sc[3], sc[4], sc[5], sc[6], sc[7]);
    pf1 = pack8(sc[8], sc[9], sc[10], sc[11], sc[12], sc[13], sc[14], sc[15]);
}
__device__ __forceinline__ void attn_unit(LAS unsigned char* lds, const Args& A, int sample, int b, int kv, int qblk, int tid) {
    const int lane = tid & 63, wave = __builtin_amdgcn_readfirstlane(tid >> 6), r = lane & 31, h = lane >> 5;
    unsigned char* ws = A.ws;
    const bf* QKV = (const bf*)(ws + WS_BIG); const bf* CK = (const bf*)(ws + WS_CK); const bf* CV = (const bf*)(ws + WS_CV);
    bf* O = (bf*)(ws + WS_XN);
    LAS bf* Ks = (LAS bf*)(lds + AT_K); LAS bf* Vt = (LAS bf*)(lds + AT_V);
    const int g = wave >> 1, qhalf = wave & 1;
    const int rowbase = sample ? MP + b * 4096 : b * 256;
    const int qstart = qblk * 128 + qhalf * 64;
    v8s qf0[4], qf1[4];
#pragma unroll
    for (int ks = 0; ks < 4; ++ks) {
        qf0[ks] = *(const v8s*)(QKV + (size_t)(rowbase + qstart + r) * AQ_LD + kv * 256 + g * 64 + 16 * ks + 8 * h);
        qf1[ks] = *(const v8s*)(QKV + (size_t)(rowbase + qstart + 32 + r) * AQ_LD + kv * 256 + g * 64 + 16 * ks + 8 * h); }
    const float sk = A.in[21][kv * 4 + g] * LOG2E;
    float m0 = sk, m1 = sk, l0 = h == 0 ? 1.f : 0.f, l1 = l0;
    v16f o00, o10, o01, o11;
#pragma unroll
    for (int i = 0; i < 16; ++i) { o00[i] = 0.f; o10[i] = 0.f; o01[i] = 0.f; o11[i] = 0.f; }
    int lo, nloc, nctx;
    if (sample) { lo = qblk * 128 - 128; if (lo < 0) lo = 0; int hi = qblk * 128 + 256; if (hi > 4096) hi = 4096; nloc = (hi - lo) >> 6; nctx = 8; }
    else { lo = 0; nloc = 4; nctx = 0; }
    const int skey = tid >> 3, sch = tid & 7;
    for (int ti = 0; ti < nloc + nctx; ++ti) {
        const bf* ksrc; const bf* vsrc; int stride, key0; bool masked;
        if (ti < nloc) { key0 = lo + ti * 64; ksrc = QKV + (size_t)(rowbase + key0) * AQ_LD + 1024 + kv * 64; vsrc = ksrc + 256; stride = AQ_LD; masked = sample != 0; }
        else { key0 = (ti - nloc) * 64; ksrc = CK + (size_t)(b * 512 + key0) * 256 + kv * 64; vsrc = CV + (size_t)(b * 512 + key0) * 256 + kv * 64; stride = 256; masked = false; }
        const v4u kk = *(const v4u*)(ksrc + (size_t)skey * stride + sch * 8), vv = *(const v4u*)(vsrc + (size_t)skey * stride + sch * 8);
        __syncthreads();
        *(LAS v4u*)(Ks + skey * 72 + sch * 8) = kk;
        { LAS bf* vp = Vt + (sch * 8) * 72 + skey;
#pragma unroll
          for (int e = 0; e < 4; ++e) { vp[(2 * e) * 72] = (bf)(vv[e] & 0xffffu); vp[(2 * e + 1) * 72] = (bf)(vv[e] >> 16); } }
        __syncthreads();
#pragma unroll 1
        for (int kb = 0; kb < 2; ++kb) {
            v8s kf[4];
#pragma unroll
            for (int ks = 0; ks < 4; ++ks) kf[ks] = *(const LAS v8s*)(Ks + (kb * 32 + r) * 72 + 16 * ks + 8 * h);
            v8s p00, p01, p10, p11;
            { v16f S0;
#pragma unroll
              for (int i = 0; i < 16; ++i) S0[i] = 0.f;
#pragma unroll
              for (int ks = 0; ks < 4; ++ks) S0 = mfma32(kf[ks], qf0[ks], S0);
              attn_qblock(S0, masked, qstart + r, key0 + kb * 32, h, m0, l0, o00, o10, p00, p01); }
            { v16f S1;
#pragma unroll
              for (int i = 0; i < 16; ++i) S1[i] = 0.f;
#pragma unroll
              for (int ks = 0; ks < 4; ++ks) S1 = mfma32(kf[ks], qf1[ks], S1);
              attn_qblock(S1, masked, qstart + 32 + r, key0 + kb * 32, h, m1, l1, o01, o11, p10, p11); }
#pragma unroll
            for (int s2 = 0; s2 < 2; ++s2) {
                const LAS bf* vp0 = Vt + r * 72 + kb * 32 + 16 * s2 + 4 * h; const LAS bf* vp1 = vp0 + 32 * 72;
                const v2u a0 = *(const LAS v2u*)vp0, a1 = *(const LAS v2u*)(vp0 + 8), b0 = *(const LAS v2u*)vp1, b1 = *(const LAS v2u*)(vp1 + 8);
                const v8s vf0 = __builtin_bit_cast(v8s, (v4u){a0.x, a0.y, a1.x, a1.y}), vf1 = __builtin_bit_cast(v8s, (v4u){b0.x, b0.y, b1.x, b1.y});
                const v8s pq0 = s2 ? p01 : p00, pq1 = s2 ? p11 : p10;
                o00 = mfma32(vf0, pq0, o00); o10 = mfma32(vf1, pq0, o10); o01 = mfma32(vf0, pq1, o01); o11 = mfma32(vf1, pq1, o11);
            }
        }
    }
    l0 += __shfl_xor(l0, 32); l1 += __shfl_xor(l1, 32);
    const float i0 = 1.0f / l0, i1 = 1.0f / l1;
    bf* op0 = O + (size_t)(rowbase + qstart + r) * DM + kv * 256 + g * 64 + 4 * h; bf* op1 = op0 + (size_t)32 * DM;
#pragma unroll
    for (int g4 = 0; g4 < 4; ++g4) {
        v2u w; w.x = pkh2(o00[4 * g4] * i0, o00[4 * g4 + 1] * i0); w.y = pkh2(o00[4 * g4 + 2] * i0, o00[4 * g4 + 3] * i0); *(v2u*)(op0 + 8 * g4) = w;
        w.x = pkh2(o10[4 * g4] * i0, o10[4 * g4 + 1] * i0); w.y = pkh2(o10[4 * g4 + 2] * i0, o10[4 * g4 + 3] * i0); *(v2u*)(op0 + 32 + 8 * g4) = w;
        w.x = pkh2(o01[4 * g4] * i1, o01[4 * g4 + 1] * i1); w.y = pkh2(o01[4 * g4 + 2] * i1, o01[4 * g4 + 3] * i1); *(v2u*)(op1 + 8 * g4) = w;
        w.x = pkh2(o11[4 * g4] * i1, o11[4 * g4 + 1] * i1); w.y = pkh2(o11[4 * g4 + 2] * i1, o11[4 * g4 + 3] * i1); *(v2u*)(op1 + 32 + 8 * g4) = w; }
    __syncthreads();
}
__device__ __forceinline__ void attn_phase(LAS unsigned char* lds, const Args& A, int tid) {
    for (int u = blockIdx.x; u < 1280; u += gridDim.x) {
        if (u < 1024) attn_unit(lds, A, 1, u >> 7, (u >> 5) & 3, u & 31, tid);
        else { const int p = u - 1024; attn_unit(lds, A, 0, p >> 3, (p >> 1) & 3, p & 1, tid); }
    }
}


#if DIAG == 2
#ifndef DG_HD
#define DG_HD 0
#endif
#ifndef DG_DIR
#define DG_DIR 0
#endif
#ifndef DG_STEPS
#define DG_STEPS 512
#endif
__device__ __forceinline__ void diag_mlstm(LAS unsigned char* lds, const Args& A, int tid) {
    if (blockIdx.x != 0) return;
    const int hd = DG_HD, dir = DG_DIR, b = 0;
    const bf* BIG = (const bf*)(A.ws + WS_BIG); const float* GATES = (const float*)(A.ws + WS_GATES);
    const bf* HD = (const bf*)(A.ws + (dir ? WS_HB : WS_XN));
    LAS float* hred = (LAS float*)lds;
    LAS float* qred = hred + 512;
    LAS float* acc = hred + 600;
    const int v = tid & 127, dg = tid >> 7;
    const int sidx = (b * 2 + dir) * 8 + hd;
    float C[16], n[16]; float m = A.in[4][sidx];
#pragma unroll
    for (int i = 0; i < 16; ++i) { C[i] = A.in[2][(size_t)sidx * 8192 + (dg * 16 + i) * 128 + v]; n[i] = A.in[3][sidx * 64 + dg * 16 + i]; }
    if (tid < 2) acc[tid] = 0.f;
    float e2 = 0.f, r2 = 0.f;
    __syncthreads();
    for (int p = 0; p < DG_STEPS; ++p) {
        const int tok = dir ? 4095 - p : p; const size_t row = (size_t)(MP + b * 4096 + tok);
        const float li = GATES[row * 32 + dir * 16 + hd], lf = log_sigmoid(GATES[row * 32 + dir * 16 + 8 + hd]);
        const float mn = fmaxf(lf + m, li), fa = expf(lf + m - mn), ia = expf(li - mn);
        const float vv = bf2f(BIG[row * QKVO_LD + 1024 + hd * 128 + v]);
        float ph = 0.f, pq = 0.f;
#pragma unroll
        for (int i = 0; i < 16; ++i) { const int d = dg * 16 + i;
            const unsigned short kq = BIG[row * QKVO_LD + 512 + hd * 64 + d], qq = BIG[row * QKVO_LD + hd * 64 + d];
            const float kk = (float)__builtin_bit_cast(_Float16, kq), q = (float)__builtin_bit_cast(_Float16, qq);
            C[i] = fa * C[i] + ia * kk * vv; n[i] = fa * n[i] + ia * kk; ph += q * C[i]; pq += q * n[i]; }
        hred[dg * 128 + v] = ph; if (v == 0) qred[dg] = pq;
        __syncthreads();
        if (dg == 0) { const float hn = hred[v] + hred[128 + v] + hred[256 + v] + hred[384 + v]; const float qn = qred[0] + qred[1] + qred[2] + qred[3];
            const float h = hn / fmaxf(fabsf(qn), expf(-mn)); const float hk = bf2f(HD[row * DM + hd * 128 + v]);
            e2 += (h - hk) * (h - hk); r2 += h * h; }
        m = mn;
        __syncthreads();
    }
    if (dg == 0) { atomicAdd((float*)acc, e2); atomicAdd((float*)acc + 1, r2); }
    __syncthreads();
    if (tid == 0) ((float*)(A.ws + WS_ROPE))[4000] = acc[0] / acc[1];
    __syncthreads();
}
#endif
constexpr int N_PHASES = 24;
#define PH_IN(k) (lo <= (k) && (k) < hi)
#define PH_SYNC(k) do { if (PH_IN(k) && (k) + 1 < hi) grid.sync(); } while (0)
template <int L>
__device__ __forceinline__ void layer_program(const Args& A, LAS unsigned char* lds, int lo, int hi, int tid, cg::grid_group& grid) {
    constexpr int B0 = 1 + 11 * L;
    constexpr bool first = (L == 0);
    constexpr size_t WL = (size_t)L * W_LAYER, MODL = (size_t)L * 9 * 9216;
#define P_X (A.out)
#define P_MOD ((const float*)(A.ws + WS_MOD) + MODL)
#define P_W ((bf*)(A.ws + WS_W))
#define P_XN ((bf*)(A.ws + WS_XN))
#define P_HB ((bf*)(A.ws + WS_HB))
#define P_BIG ((bf*)(A.ws + WS_BIG))
    if (PH_IN(B0 + 0)) { if (EN(1)) norm_phase<2>(first ? A.in[0] : P_X, first ? A.in[1] - (size_t)MP * DM : P_X, P_XN, nullptr, A.in[11] + (size_t)(L * 3 + 0) * DM, P_MOD + 0 * 1024, tid); }
    PH_SYNC(B0 + 0);
    if (PH_IN(B0 + 1)) { pg8::Gemm g{P_XN, P_W + WL, MT, 5632, 1024}; pg8::StaticOrder S; S.init(MT, 5632, (int)gridDim.x, (int)blockIdx.x); EpiSwiglu E{P_BIG};
        if (EN(2)) pg8::gemm_phase<EpiSwiglu, pg8::StaticOrder, true, true>(lds, g, S, E); }
    PH_SYNC(B0 + 1);
    if (PH_IN(B0 + 2)) { pg8::Gemm g{P_BIG, P_W + WL + W_GU, MT, 1024, DFF}; pg8::StaticOrder S; S.init(MT, 1024, (int)gridDim.x, (int)blockIdx.x);
        EpiResid E{first ? A.in[0] : P_X, first ? A.in[1] - (size_t)MP * DM : P_X, P_X, P_MOD + 2 * 1024, 0.5f};
        if (EN(3)) pg8::gemm_phase<EpiResid, pg8::StaticOrder, true, true>(lds, g, S, E); }
    PH_SYNC(B0 + 2);
    if (PH_IN(B0 + 3)) { if (EN(1)) norm_phase<2>(P_X, P_X, P_XN, nullptr, A.in[11] + (size_t)(L * 3 + 1) * DM, P_MOD + 3 * 1024, tid); }
    PH_SYNC(B0 + 3);
    if (PH_IN(B0 + 4)) {
        if constexpr (first) { pg8::Gemm g{P_XN, P_W + W_MI, MT, MI_N, 1024}; pg8::StaticOrder S; S.init(MT, MI_N, (int)gridDim.x, (int)blockIdx.x);
            EpiMlstmIn E{P_BIG, (float*)(A.ws + WS_GATES), A.in[17]};
            if (EN(4)) pg8::gemm_phase<EpiMlstmIn, pg8::StaticOrder, true, true>(lds, g, S, E); }
        else { pg8::Gemm g{P_XN, P_W + W_AI, MT, 1536, 1024}; pg8::StaticOrder S; S.init(MT, 1536, (int)gridDim.x, (int)blockIdx.x);
            EpiAttnIn E{P_BIG, A.out + OUT_CK, A.out + OUT_CV, (const float*)(A.ws + WS_ROPE)};
            if (EN(5)) pg8::gemm_phase<EpiAttnIn, pg8::StaticOrder, true, true>(lds, g, S, E); } }
    PH_SYNC(B0 + 4);
    if (PH_IN(B0 + 5)) { if constexpr (first) { if (EN(6)) mlstm_phase(lds, A, tid); }
    }
    PH_SYNC(B0 + 5);
    if (PH_IN(B0 + 5)) {
#if DIAG == 2
        if constexpr (first) diag_mlstm(lds, A, tid);
#endif
        if constexpr (first) {} else { if (EN(7)) attn_phase(lds, A, tid); } }
    PH_SYNC(B0 + 5);
    if constexpr (first) {
        if (PH_IN(B0 + 6)) { if (EN(8)) combine_phase(P_XN, P_HB, P_BIG, A.in[18], tid); }
        PH_SYNC(B0 + 6);
    }
    if (PH_IN(B0 + 7)) { pg8::Gemm g{P_XN, P_W + (first ? W_MO : W_AO), MT, 1024, 1024}; pg8::StaticOrder S; S.init(MT, 1024, (int)gridDim.x, (int)blockIdx.x);
        EpiResid E{P_X, P_X, P_X, P_MOD + 5 * 1024, 1.0f};
        if (EN(3)) pg8::gemm_phase<EpiResid, pg8::StaticOrder, true, true>(lds, g, S, E); }
    PH_SYNC(B0 + 7);
    if (PH_IN(B0 + 8)) { if (EN(1)) norm_phase<2>(P_X, P_X, P_XN, nullptr, A.in[11] + (size_t)(L * 3 + 2) * DM, P_MOD + 6 * 1024, tid); }
    PH_SYNC(B0 + 8);
    if (PH_IN(B0 + 9)) { pg8::Gemm g{P_XN, P_W + WL + W_GU + W_DN, MT, 5632, 1024}; pg8::StaticOrder S; S.init(MT, 5632, (int)gridDim.x, (int)blockIdx.x); EpiSwiglu E{P_BIG};
        if (EN(2)) pg8::gemm_phase<EpiSwiglu, pg8::StaticOrder, true, true>(lds, g, S, E); }
    PH_SYNC(B0 + 9);
    if (PH_IN(B0 + 10)) { pg8::Gemm g{P_BIG, P_W + WL + 2 * W_GU + W_DN, MT, 1024, DFF}; pg8::StaticOrder S; S.init(MT, 1024, (int)gridDim.x, (int)blockIdx.x);
        EpiResid E{P_X, P_X, P_X, P_MOD + 8 * 1024, 0.5f};
        if (EN(3)) pg8::gemm_phase<EpiResid, pg8::StaticOrder, true, true>(lds, g, S, E); }
    PH_SYNC(B0 + 10);
}
__global__ void __launch_bounds__(NTHR, 2) fwd_megakernel(Args A) {
    extern __shared__ __attribute__((aligned(16))) unsigned char lds_raw[];
    LAS unsigned char* lds = (LAS unsigned char*)lds_raw;
    cg::grid_group grid = cg::this_grid();
    const int tid = threadIdx.x;
    const int lo = A.ph_lo, hi = A.ph_hi;
    if (PH_IN(0)) { if (EN(0)) prologue(A, lds, tid); }
    PH_SYNC(0);
    layer_program<0>(A, lds, lo, hi, tid, grid);
    layer_program<1>(A, lds, lo, hi, tid, grid);
    if (PH_IN(N_PHASES - 1)) { if (EN(1)) norm_phase<1>(P_X, P_X, nullptr, P_X, A.in[23], (const float*)(A.ws + WS_ROPE), tid); }
}

extern "C" void kernel_launch(void* const* d_in, const int* in_sizes, int n_in, void* d_out, int out_size, void* d_ws, size_t ws_size, hipStream_t stream) {
    static int grid = 0;
    if (grid == 0) {
        if (n_in != 24 || (size_t)out_size != OUT_TOTAL || ws_size < WS_END) { fprintf(stderr, "kernel_launch: unexpected shapes (n_in %d out %d ws %zu)\n", n_in, out_size, ws_size); grid = -1; return; }
        int dev = 0, cus = 0, per_cu = 0;
        if (hipGetDevice(&dev) != hipSuccess || hipDeviceGetAttribute(&cus, hipDeviceAttributeMultiprocessorCount, dev) != hipSuccess) { grid = -1; return; }
        if (hipFuncSetAttribute((const void*)fwd_megakernel, hipFuncAttributeMaxDynamicSharedMemorySize, LDS_BYTES) != hipSuccess) { fprintf(stderr, "kernel_launch: hipFuncSetAttribute failed\n"); grid = -1; return; }
        if (hipOccupancyMaxActiveBlocksPerMultiprocessor(&per_cu, (const void*)fwd_megakernel, NTHR, LDS_BYTES) != hipSuccess || per_cu < 1) per_cu = 1;
        (void)hipGetLastError();
        grid = cus * per_cu;
        if (grid > 256) grid = 256;
    }
    if (grid < 0) return;
    Args a{};
    for (int i = 0; i < 24; ++i) a.in[i] = (const float*)d_in[i];
    a.out = (float*)d_out; a.ws = (unsigned char*)d_ws;
#if ONE_LAUNCH
    a.ph_lo = 0; a.ph_hi = N_PHASES;
    void* args[] = {&a};
    hipError_t e = hipLaunchCooperativeKernel((const void*)fwd_megakernel, dim3(grid), dim3(NTHR), args, LDS_BYTES, stream);
    if (e != hipSuccess) fprintf(stderr, "cooperative launch failed: %s (grid %d)\n", hipGetErrorString(e), grid);
#else
    for (int p = 0; p < N_PHASES; ++p) {
        if (p == 18) continue;
        a.ph_lo = p; a.ph_hi = p + 1;
        hipLaunchKernelGGL(fwd_megakernel, dim3(grid), dim3(NTHR), LDS_BYTES, stream, a);
    }
#endif
}
```

```cpp
#include <hip/hip_runtime.h>
#include <hip/hip_cooperative_groups.h>
#include <cstdio>
#include <cstdint>
namespace cg = cooperative_groups;
namespace pg8 {
#define PG8_LAS __attribute__((address_space(3)))
typedef unsigned short bf16_t;
typedef short bf16x8 __attribute__((ext_vector_type(8)));
typedef float f32x4 __attribute__((ext_vector_type(4)));
typedef unsigned u32x4 __attribute__((ext_vector_type(4)));
constexpr int BM = 256, BK = 64, HALF = 128, HTB = HALF * BK * 2  , STAGE_BYTES = 8 * HTB, NXCD = 8, WGM = 8;

__host__ __device__ __forceinline__ int lds_byte(int r, int c) { const int st = (r >> 4) * 2 + (c >> 5), rr = r & 15, cc = c & 31, ob = rr * 64 + cc * 2; return st * 1024 + (ob ^ (((ob >> 9) & 1) << 5)); }
__host__ __device__ __forceinline__ void stage_rc(int b, int& R, int& C) { const int st = b / 1024, sb = b % 1024, swz = sb ^ (((sb >> 9) & 1) << 5); R = (st >> 1) * 16 + swz / 64; C = (st & 1) * 32 + (swz % 64) / 2; }
__host__ __device__ __forceinline__ int perm32(int rho) { const int n = rho >> 4, i = rho & 15; return 8 * (i >> 2) + 4 * n + (i & 3); }

typedef _Float16 f16x8 __attribute__((ext_vector_type(8)));
template <bool F16> __device__ __forceinline__ f32x4 mma16(bf16x8 a, bf16x8 b, f32x4 c) {
    if constexpr (F16) return __builtin_amdgcn_mfma_f32_16x16x32_f16(__builtin_bit_cast(f16x8, a), __builtin_bit_cast(f16x8, b), c, 0, 0, 0);
    else return __builtin_amdgcn_mfma_f32_16x16x32_bf16(a, b, c, 0, 0, 0);
}
struct Unit { int pm, pn; };
struct Gemm { const bf16_t* A; const bf16_t* Bt; int M, N, K; };

struct StaticOrder {
    int nM, nN, nwg, G, c;
    __host__ __device__ void init(int M, int N, int G_, int c_) { nM = M / BM; nN = N / BM; nwg = nM * nN; G = G_; c = c_; }
    __host__ __device__ bool next(int i, Unit& u) const {
        const long L = (long)i * G + c; if (L >= nwg) return false;
        int wgid = (int)L; { const int q = nwg / NXCD, r = nwg % NXCD, xcd = wgid % NXCD, off = wgid / NXCD; wgid = (xcd < r ? xcd * (q + 1) : r * (q + 1) + (xcd - r) * q) + off; }
        const int nig = WGM * nN, gid = wgid / nig, fm = gid * WGM, gsz = (nM - fm) < WGM ? (nM - fm) : WGM;
        u.pm = fm + ((wgid % nig) % gsz); u.pn = (wgid % nig) / gsz; return true;
    }
    __device__ __forceinline__ void a_ready(const Unit&) const {}
    __device__ __forceinline__ void done(const Unit&) const {}
};

__device__ __forceinline__ unsigned cvt_pk_bf16(float lo, float hi) { unsigned r; asm volatile("v_cvt_pk_bf16_f32 %0, %1, %2" : "=v"(r) : "v"(lo), "v"(hi)); return r; }
typedef float f32x2 __attribute__((ext_vector_type(2)));
__device__ __forceinline__ f32x2 gelu_pk(f32x2 v) {
    const f32x2 av = __builtin_elementwise_abs(v), d = av * 0.2316418882f + 1.0f;
    f32x2 t; t.x = __builtin_amdgcn_rcpf(d.x); t.y = __builtin_amdgcn_rcpf(d.y);
    f32x2 q = t * 0.5307027145f + (-0.7265760135f); q = q * t + 0.7107068705f; q = q * t + (-0.142248368f); q = q * t + 0.127414796f; q = q * t;
    const f32x2 s = (v * v) * (-0.72134752044f);
    f32x2 e; e.x = __builtin_amdgcn_exp2f(s.x); e.y = __builtin_amdgcn_exp2f(s.y);
    const f32x2 m = v * (q * e), r = v - m;
    f32x2 o; o.x = v.x < 0.f ? m.x : r.x; o.y = v.y < 0.f ? m.y : r.y; return o;
}

template <int ACT  > struct EpiBf16 {
    static constexpr bool PERM = true, AFTER_DRAIN = false; static_assert(ACT == 0 || ACT == 1, "EpiBf16: ACT is 0 (none) or 1 (gelu_pk)");
    bf16_t* O; int ldc; const float* bias; int split_cols; size_t split_stride; float scale0;
    __device__ __forceinline__ void operator()(const f32x4 (&acc)[2][2][4][2], const Unit& u, int wr, int wc, int fr, int fq) const {
        const int row0 = u.pm * BM + wr * 64 + fr; int colt = u.pn * BM; bf16_t* base = O;
        float sc = 1.f; if (split_cols) { const int t = colt / split_cols; base += (size_t)t * split_stride; colt -= t * split_cols; if (t == 0) sc = scale0; }
        const int col0 = colt + wc * 32 + 8 * fq, bcol0 = u.pn * BM + wc * 32 + 8 * fq;
        f32x4 bv[2][2];
#pragma unroll
        for (int bj = 0; bj < 2; ++bj)
#pragma unroll
            for (int n = 0; n < 2; ++n) bv[bj][n] = bias ? *(const f32x4*)(bias + bcol0 + bj * HALF + 4 * n) : (f32x4){0.f, 0.f, 0.f, 0.f};
#pragma unroll
        for (int ai = 0; ai < 2; ++ai)
#pragma unroll
            for (int m = 0; m < 4; ++m) { bf16_t* rowp = base + (size_t)(row0 + ai * HALF + m * 16) * ldc + col0;
#pragma unroll
                for (int bj = 0; bj < 2; ++bj) { f32x4 v0 = acc[ai][bj][m][0] + bv[bj][0], v1 = acc[ai][bj][m][1] + bv[bj][1];
                    if (ACT == 1) { f32x2 a = gelu_pk((f32x2){v0[0], v0[1]}), b = gelu_pk((f32x2){v0[2], v0[3]}), c = gelu_pk((f32x2){v1[0], v1[1]}), d = gelu_pk((f32x2){v1[2], v1[3]});
                        v0 = (f32x4){a.x, a.y, b.x, b.y}; v1 = (f32x4){c.x, c.y, d.x, d.y}; }
                    v0 = v0 * sc; v1 = v1 * sc; u32x4 w; w.x = cvt_pk_bf16(v0[0], v0[1]); w.y = cvt_pk_bf16(v0[2], v0[3]); w.z = cvt_pk_bf16(v1[0], v1[1]); w.w = cvt_pk_bf16(v1[2], v1[3]);
                    *(u32x4*)(rowp + bj * HALF) = w; } }
    }
};

struct PanelStats {
    unsigned* xbuf;
    unsigned* cnt;
    unsigned* tmo;
    int ntn; float eps;
    unsigned code;
    __device__ __forceinline__ bool run(const f32x4 (&v)[2][2][4][2], const Unit& u, int wr, int wc, int fr, int fq, PG8_LAS unsigned char* lds, int wid, int lane) const {
        typedef float f32x2v __attribute__((ext_vector_type(2)));
        PG8_LAS f32x2v* P = (PG8_LAS f32x2v*)lds;
        PG8_LAS f32x2v* S = (PG8_LAS f32x2v*)(lds + 8192);
        PG8_LAS unsigned* flag = (PG8_LAS unsigned*)(lds + 8192 + 2048);
#pragma unroll
        for (int ai = 0; ai < 2; ++ai)
#pragma unroll
            for (int m = 0; m < 4; ++m) {
                float s = 0.f;
#pragma unroll
                for (int bj = 0; bj < 2; ++bj)
#pragma unroll
                    for (int n = 0; n < 2; ++n) { const f32x4 x = v[ai][bj][m][n]; s += (x[0] + x[1]) + (x[2] + x[3]); }
                s += __shfl_xor(s, 16); s += __shfl_xor(s, 32);
                const float mw = s * (1.0f / 64.0f); float q = 0.f;
#pragma unroll
                for (int bj = 0; bj < 2; ++bj)
#pragma unroll
                    for (int n = 0; n < 2; ++n) { const f32x4 d = v[ai][bj][m][n] - mw; q += (d[0] * d[0] + d[1] * d[1]) + (d[2] * d[2] + d[3] * d[3]); }
                q += __shfl_xor(q, 16); q += __shfl_xor(q, 32);
                if (fq == 0) P[(ai * HALF + wr * 64 + m * 16 + fr) * 4 + wc] = (f32x2v){mw, q};
            }
        asm volatile("s_waitcnt lgkmcnt(0)" ::: "memory"); __builtin_amdgcn_s_barrier(); asm volatile("" ::: "memory");
#if defined(BROKEN_EXCHANGE_NO_WAIT)
#warning BROKEN CONTROL BUILD: the row-statistics exchange does not wait; results are wrong by design
        if (blockIdx.x >= 64) { const long long t0_ = clock64(); while (clock64() - t0_ < 60000) __builtin_amdgcn_s_sleep(8); }
#endif
        const int row = wid * 32 + (lane & 31);
        if (lane < 32) {
            const f32x2v a = P[row * 4 + 0], b = P[row * 4 + 1], c = P[row * 4 + 2], d = P[row * 4 + 3];
            const float mt = (a.x + b.x + c.x + d.x) * 0.25f;
            const float da = a.x - mt, db = b.x - mt, dc = c.x - mt, dd = d.x - mt;
            const float m2 = (a.y + b.y) + (c.y + d.y) + 64.0f * ((da * da + db * db) + (dc * dc + dd * dd));
            unsigned long long* slot = (unsigned long long*)xbuf + ((size_t)(u.pm * BM + row) * 4 + u.pn);
            __hip_atomic_store(slot, ((unsigned long long)__float_as_uint(m2) << 32) | __float_as_uint(mt), __ATOMIC_RELAXED, __HIP_MEMORY_SCOPE_AGENT);
        }
        asm volatile("s_waitcnt vmcnt(0)" ::: "memory");
        if (lane == 0) __hip_atomic_fetch_add(cnt + 64 * u.pm, 1u, __ATOMIC_RELAXED, __HIP_MEMORY_SCOPE_AGENT);
        if (wid == 0) {
            bool dead = false; const unsigned long long t0 = __builtin_amdgcn_s_memrealtime(); const unsigned want = 8u * (unsigned)ntn;
            for (;;) {
#if defined(BROKEN_EXCHANGE_NO_WAIT)
                break;
#endif
                if ((unsigned)__builtin_amdgcn_readfirstlane(__hip_atomic_load(cnt + 64 * u.pm, __ATOMIC_RELAXED, __HIP_MEMORY_SCOPE_AGENT)) >= want) break;
                if (__builtin_amdgcn_s_memrealtime() - t0 > 2000000ull) {
                    if (lane == 0) { unsigned expect = 0u; __hip_atomic_compare_exchange_strong(tmo + 1, &expect, code | (unsigned)(u.pm & 0xff), __ATOMIC_RELAXED, __ATOMIC_RELAXED, __HIP_MEMORY_SCOPE_AGENT);
                                     __hip_atomic_store(tmo, 1u, __ATOMIC_RELAXED, __HIP_MEMORY_SCOPE_AGENT); }
                    dead = true; break; }
                __builtin_amdgcn_s_sleep(2);
            }
            __builtin_amdgcn_fence(__ATOMIC_ACQUIRE, "agent");
            if (lane == 0) flag[0] = dead ? 1u : 0u;
        }
        asm volatile("s_waitcnt vmcnt(0) lgkmcnt(0)" ::: "memory"); __builtin_amdgcn_s_barrier(); asm volatile("" ::: "memory");
        const bool bad = flag[0] != 0u;
        if (lane < 32) {
            const unsigned long long* slot = (const unsigned long long*)xbuf + (size_t)(u.pm * BM + row) * 4; float mt[4], m2[4]; float ms = 0.f;
#pragma unroll
            for (int t = 0; t < 4; ++t) { if (t < ntn) { const unsigned long long w = __hip_atomic_load(slot + t, __ATOMIC_RELAXED, __HIP_MEMORY_SCOPE_AGENT); mt[t] = __uint_as_float((unsigned)w); m2[t] = __uint_as_float((unsigned)(w >> 32)); } else { mt[t] = 0.f; m2[t] = 0.f; } ms += mt[t]; }
            const float mean = ms / (float)ntn; float q = 0.f;
#pragma unroll
            for (int t = 0; t < 4; ++t) if (t < ntn) { const float dm = mt[t] - mean; q += m2[t] + 256.0f * dm * dm; }
            S[row] = (f32x2v){mean, 1.0f / sqrtf(q / (256.0f * (float)ntn) + eps)};
        }
        asm volatile("s_waitcnt lgkmcnt(0)" ::: "memory"); __builtin_amdgcn_s_barrier(); asm volatile("" ::: "memory");
        return bad;
    }
};
struct EpiLnRes {
    static constexpr bool PERM = false, AFTER_DRAIN = true;
    const float* base; float* out; int ldc; const float* bias; PanelStats st; unsigned poison;
    __device__ __forceinline__ void fused(f32x4 (&acc)[2][2][4][2], const Unit& u, int wr, int wc, int fr, int fq, PG8_LAS unsigned char* lds, int wid, int lane) const {
        typedef float f32x2v __attribute__((ext_vector_type(2)));
        const PG8_LAS f32x2v* S = (const PG8_LAS f32x2v*)(lds + 8192);
        const int col0 = u.pn * BM + wc * 32 + 4 * fq;
#pragma unroll
        for (int bj = 0; bj < 2; ++bj)
#pragma unroll
            for (int n = 0; n < 2; ++n) { const f32x4 bv = bias ? *(const f32x4*)(bias + col0 + bj * HALF + n * 16) : (f32x4){0.f, 0.f, 0.f, 0.f};
#pragma unroll
                for (int ai = 0; ai < 2; ++ai)
#pragma unroll
                    for (int m = 0; m < 4; ++m) acc[ai][bj][m][n] += bv; }
        f32x4 pre[4][2][2];
#pragma unroll
        for (int m = 0; m < 4; ++m) { const size_t off = (size_t)(u.pm * BM + wr * 64 + m * 16 + fr) * ldc + col0;
#pragma unroll
            for (int bj = 0; bj < 2; ++bj)
#pragma unroll
                for (int n = 0; n < 2; ++n) pre[m][bj][n] = *(const f32x4*)(base + off + bj * HALF + n * 16); }
        const bool bad = st.run(acc, u, wr, wc, fr, fq, lds, wid, lane) || poison != 0u;
        const float qnan = __builtin_nanf("");
#pragma unroll
        for (int ai = 0; ai < 2; ++ai)
#pragma unroll
            for (int m = 0; m < 4; ++m) { const int r = ai * HALF + wr * 64 + m * 16 + fr; const f32x2v sr = S[r]; const size_t off = (size_t)(u.pm * BM + r) * ldc + col0;
#pragma unroll
                for (int bj = 0; bj < 2; ++bj)
#pragma unroll
                    for (int n = 0; n < 2; ++n) { const f32x4 bs = ai == 0 ? pre[m][bj][n] : *(const f32x4*)(base + off + bj * HALF + n * 16); f32x4 o = bs + (acc[ai][bj][m][n] - sr.x) * sr.y;
                        if (bad) o = (f32x4){qnan, qnan, qnan, qnan}; *(f32x4*)(out + off + bj * HALF + n * 16) = o; }
                if (m & 1) asm volatile("" ::: "memory"); }
    }
};
struct EpiLnResLn {
    static constexpr bool PERM = false, AFTER_DRAIN = true;
    const float* base; float* out; bf16_t* xn; int ldc; const float* bias; PanelStats st1, st2; unsigned poison;
    __device__ __forceinline__ void fused(f32x4 (&acc)[2][2][4][2], const Unit& u, int wr, int wc, int fr, int fq, PG8_LAS unsigned char* lds, int wid, int lane) const {
        typedef float f32x2v __attribute__((ext_vector_type(2))); typedef unsigned u32x2v __attribute__((ext_vector_type(2)));
        const PG8_LAS f32x2v* S = (const PG8_LAS f32x2v*)(lds + 8192);
        const int col0 = u.pn * BM + wc * 32 + 4 * fq;
#pragma unroll
        for (int bj = 0; bj < 2; ++bj)
#pragma unroll
            for (int n = 0; n < 2; ++n) { const f32x4 bv = bias ? *(const f32x4*)(bias + col0 + bj * HALF + n * 16) : (f32x4){0.f, 0.f, 0.f, 0.f};
#pragma unroll
                for (int ai = 0; ai < 2; ++ai)
#pragma unroll
                    for (int m = 0; m < 4; ++m) acc[ai][bj][m][n] += bv; }
        bool bad = st1.run(acc, u, wr, wc, fr, fq, lds, wid, lane) || poison != 0u;
        const float qnan = __builtin_nanf("");
#pragma unroll
        for (int ai = 0; ai < 2; ++ai)
#pragma unroll
            for (int m = 0; m < 4; ++m) { const int r = ai * HALF + wr * 64 + m * 16 + fr; const f32x2v sr = S[r]; const size_t off = (size_t)(u.pm * BM + r) * ldc + col0;
#pragma unroll
                for (int bj = 0; bj < 2; ++bj)
#pragma unroll
                    for (int n = 0; n < 2; ++n) { const f32x4 bs = *(const f32x4*)(base + off + bj * HALF + n * 16); acc[ai][bj][m][n] = bs + (acc[ai][bj][m][n] - sr.x) * sr.y; }
                asm volatile("" : "+v"(acc[ai][0][m][0]), "+v"(acc[ai][0][m][1]), "+v"(acc[ai][1][m][0]), "+v"(acc[ai][1][m][1]));
                if (m & 1) asm volatile("" ::: "memory"); }
        const bool bad1 = bad;
        bad = st2.run(acc, u, wr, wc, fr, fq, lds, wid, lane) || bad;
#pragma unroll
        for (int ai = 0; ai < 2; ++ai)
#pragma unroll
            for (int m = 0; m < 4; ++m) { const int r = ai * HALF + wr * 64 + m * 16 + fr; const f32x2v sr = S[r]; const size_t off = (size_t)(u.pm * BM + r) * ldc + col0;
#pragma unroll
                for (int bj = 0; bj < 2; ++bj)
#pragma unroll
                    for (int n = 0; n < 2; ++n) { const f32x4 x1 = acc[ai][bj][m][n]; *(f32x4*)(out + off + bj * HALF + n * 16) = bad1 ? (f32x4){qnan, qnan, qnan, qnan} : x1;
                        const f32x4 o = (x1 - sr.x) * sr.y; u32x2v w; w.x = cvt_pk_bf16(o[0], o[1]); w.y = cvt_pk_bf16(o[2], o[3]);
                        if (bad) { w.x = 0x7fc07fc0u; w.y = 0x7fc07fc0u; } *(u32x2v*)(xn + off + bj * HALF + n * 16) = w; }
                asm volatile("" ::: "memory"); }
    }
};

template <class Epi, class Sched, bool ALIGN_EPI = false, bool SP2 = false>
__device__ __forceinline__ void gemm_phase(PG8_LAS unsigned char* lds, const Gemm g, const Sched& S, const Epi& E) {
    const int tid = threadIdx.x, wid = __builtin_amdgcn_readfirstlane(tid >> 6), lane = tid & 63, wr = wid >> 2, wc = wid & 3, fr = lane & 15, fq = lane >> 4;
    const int K = g.K, nt = K / BK;
    unsigned voffA[2], voffB[2];
#pragma unroll
    for (int i = 0; i < 2; ++i) { int R, C; stage_rc(tid * 16 + i * 8192, R, C); const int Rb = Epi::PERM ? ((R & ~31) + perm32(R & 31)) : R;
        voffA[i] = (unsigned)(R * K + C) * 2u; voffB[i] = (unsigned)(Rb * K + C) * 2u; }
    const size_t kstep = (size_t)(BK * 2);
    const size_t hstep = (size_t)HALF * K * 2;
    const size_t tstep = 2 * hstep;
    const unsigned ldsw = (unsigned)wid * 1024u;
    const int aoff = lds_byte(wr * 64 + fr, fq * 8), boff = lds_byte(wc * 32 + fr, fq * 8);
#define PG8_SA(b, h) (((b) * 2 + (h)) * HTB)
#define PG8_SB(b, h) ((4 + (b) * 2 + (h)) * HTB)
#define PG8_STAGE(bufoff, gbase, voff) do { _Pragma("unroll") for (int _i = 0; _i < 2; ++_i) \
        __builtin_amdgcn_global_load_lds((const unsigned*)((const char*)(gbase) + (voff)[_i]), (PG8_LAS unsigned*)(lds + (bufoff) + ldsw + _i * 8192), 16, 0, 0); } while (0)
#define PG8_LDA(dst, b, h) do { _Pragma("unroll") for (int m = 0; m < 4; ++m) _Pragma("unroll") for (int k = 0; k < 2; ++k) dst[m][k] = *(const PG8_LAS bf16x8*)(lds + PG8_SA(b, h) + aoff + m * 2048 + k * 1024); } while (0)
#define PG8_LDB(dst, b, h) do { _Pragma("unroll") for (int n = 0; n < 2; ++n) _Pragma("unroll") for (int k = 0; k < 2; ++k) dst[n][k] = *(const PG8_LAS bf16x8*)(lds + PG8_SB(b, h) + boff + n * 2048 + k * 1024); } while (0)
#define PG8_MMA(ai, bj, At, Bt) do { __builtin_amdgcn_s_setprio(1); _Pragma("unroll") for (int m = 0; m < 4; ++m) _Pragma("unroll") for (int n = 0; n < 2; ++n) _Pragma("unroll") for (int k = 0; k < 2; ++k) \
        acc[ai][bj][m][n] = mma16<Epi::F16>(Bt[n][k], At[m][k], acc[ai][bj][m][n]); __builtin_amdgcn_s_setprio(0); } while (0)
#define PG8_WAIT_V(n) asm volatile("s_waitcnt vmcnt(" #n ")" ::: "memory")
#define PG8_WAIT_L(n) asm volatile("s_waitcnt lgkmcnt(" #n ")" ::: "memory")
#define PG8_BAR __builtin_amdgcn_s_barrier()
#define PG8_SCHED __builtin_amdgcn_sched_barrier(0)
    Unit cur, nxt; int ui = 0;
    if (!S.next(0, cur)) return;
    f32x4 acc[2][2][4][2];
#pragma unroll
    for (int a = 0; a < 2; ++a)
#pragma unroll
        for (int b = 0; b < 2; ++b)
#pragma unroll
            for (int m = 0; m < 4; ++m)
#pragma unroll
                for (int n = 0; n < 2; ++n) acc[a][b][m][n] = (f32x4){0.f, 0.f, 0.f, 0.f};
    bf16x8 At[4][2], B0[2][2], B1[2][2];
    const char* cA = (const char*)g.A + (size_t)cur.pm * tstep; const char* cB = (const char*)g.Bt + (size_t)cur.pn * tstep;
    S.a_ready(cur);
    if constexpr (SP2) {
        PG8_STAGE(PG8_SB(0, 0), cB, voffB); PG8_STAGE(PG8_SB(0, 1), cB + hstep, voffB); PG8_STAGE(PG8_SA(0, 0), cA, voffA); PG8_STAGE(PG8_SA(0, 1), cA + hstep, voffA);
        if (wr == 1) PG8_BAR;
        PG8_WAIT_V(2); PG8_BAR;
        PG8_STAGE(PG8_SB(1, 0), cB + kstep, voffB); PG8_STAGE(PG8_SA(1, 0), cA + kstep, voffA); PG8_STAGE(PG8_SB(1, 1), cB + hstep + kstep, voffB);
        PG8_WAIT_V(6); PG8_BAR;
    } else {
        PG8_STAGE(PG8_SB(0, 0), cB, voffB); PG8_STAGE(PG8_SA(0, 0), cA, voffA); PG8_STAGE(PG8_SB(0, 1), cB + hstep, voffB); PG8_STAGE(PG8_SA(0, 1), cA + hstep, voffA);
        if (wr == 1) PG8_BAR;
        PG8_WAIT_V(4); PG8_BAR;
        PG8_STAGE(PG8_SB(1, 0), cB + kstep, voffB); PG8_STAGE(PG8_SA(1, 0), cA + kstep, voffA); PG8_STAGE(PG8_SB(1, 1), cB + hstep + kstep, voffB);
        PG8_WAIT_V(6); PG8_BAR;
    }
    for (;;) {
        const bool has_next = S.next(ui + 1, nxt);
        const char* nA = has_next ? (const char*)g.A + (size_t)nxt.pm * tstep : cA; const char* nB = has_next ? (const char*)g.Bt + (size_t)nxt.pn * tstep : cB;
        for (int t = 0; t < nt; t += 2) {
            const bool last = (t == nt - 2);
            const char* a1 = cA + (size_t)(t + 1) * kstep;
            const char* a2 = last ? nA : cA + (size_t)(t + 2) * kstep; const char* b2 = last ? nB : cB + (size_t)(t + 2) * kstep;
            const char* a3 = a2 + kstep; const char* b3 = b2 + kstep;
            if (last && has_next) S.a_ready(nxt);
            if constexpr (SP2) {
            PG8_LDB(B0, 0, 0); PG8_LDB(B1, 0, 1); PG8_SCHED; PG8_LDA(At, 0, 0); PG8_STAGE(PG8_SA(1, 1), a1 + hstep, voffA);
            PG8_WAIT_V(8); PG8_WAIT_L(0); PG8_BAR; PG8_MMA(0, 0, At, B0); PG8_MMA(0, 1, At, B1); PG8_BAR; PG8_SCHED;
            PG8_LDA(At, 0, 1); PG8_STAGE(PG8_SB(0, 0), b2, voffB); PG8_STAGE(PG8_SB(0, 1), b2 + hstep, voffB); PG8_STAGE(PG8_SA(0, 0), a2, voffA);
            PG8_WAIT_V(8); PG8_WAIT_L(0); PG8_BAR; PG8_MMA(1, 0, At, B0); PG8_MMA(1, 1, At, B1); PG8_BAR; PG8_SCHED;
            PG8_LDB(B0, 1, 0); PG8_LDB(B1, 1, 1); PG8_SCHED; PG8_LDA(At, 1, 0); PG8_STAGE(PG8_SA(0, 1), a2 + hstep, voffA);
            PG8_WAIT_V(8); PG8_WAIT_L(0); PG8_BAR; PG8_MMA(0, 0, At, B0); PG8_MMA(0, 1, At, B1); PG8_BAR; PG8_SCHED;
            PG8_LDA(At, 1, 1); PG8_STAGE(PG8_SB(1, 0), b3, voffB); PG8_STAGE(PG8_SB(1, 1), b3 + hstep, voffB); PG8_STAGE(PG8_SA(1, 0), a3, voffA);
            PG8_WAIT_V(8); PG8_WAIT_L(0); PG8_BAR; PG8_MMA(1, 0, At, B0); PG8_MMA(1, 1, At, B1); PG8_BAR; PG8_SCHED;
            } else {
            PG8_LDB(B0, 0, 0); PG8_SCHED; PG8_LDA(At, 0, 0); PG8_STAGE(PG8_SA(1, 1), a1 + hstep, voffA);
            PG8_WAIT_L(8); PG8_BAR; PG8_WAIT_L(0); PG8_MMA(0, 0, At, B0); PG8_BAR; PG8_SCHED;
            PG8_LDB(B1, 0, 1); PG8_STAGE(PG8_SB(0, 0), b2, voffB);
            PG8_BAR; PG8_WAIT_L(0); PG8_MMA(0, 1, At, B1); PG8_BAR;
            PG8_LDA(At, 0, 1); PG8_STAGE(PG8_SA(0, 0), a2, voffA);
            PG8_BAR; PG8_WAIT_L(0); PG8_MMA(1, 0, At, B0); PG8_BAR; PG8_SCHED;
            PG8_STAGE(PG8_SB(0, 1), b2 + hstep, voffB);
            PG8_WAIT_V(6); PG8_BAR; PG8_MMA(1, 1, At, B1); PG8_BAR;
            PG8_LDB(B0, 1, 0); PG8_SCHED; PG8_LDA(At, 1, 0); PG8_STAGE(PG8_SA(0, 1), a2 + hstep, voffA);
            PG8_WAIT_L(8); PG8_BAR; PG8_WAIT_L(0); PG8_MMA(0, 0, At, B0); PG8_BAR; PG8_SCHED;
            PG8_LDB(B1, 1, 1); PG8_STAGE(PG8_SB(1, 0), b3, voffB);
            PG8_BAR; PG8_WAIT_L(0); PG8_MMA(0, 1, At, B1); PG8_BAR;
            PG8_LDA(At, 1, 1); PG8_STAGE(PG8_SA(1, 0), a3, voffA);
            PG8_BAR; PG8_WAIT_L(0); PG8_MMA(1, 0, At, B0); PG8_BAR; PG8_SCHED;
            PG8_STAGE(PG8_SB(1, 1), b3 + hstep, voffB);
            PG8_WAIT_V(6); PG8_BAR; PG8_MMA(1, 1, At, B1); PG8_BAR;
            }
        }
        if constexpr (ALIGN_EPI) { if (wr == 0) PG8_BAR; }
        if constexpr (!Epi::AFTER_DRAIN) { E(acc, cur, wr, wc, fr, fq); S.done(cur); }
        if (!has_next) break;
#pragma unroll
        for (int a = 0; a < 2; ++a)
#pragma unroll
            for (int b = 0; b < 2; ++b)
#pragma unroll
                for (int m = 0; m < 4; ++m)
#pragma unroll
                    for (int n = 0; n < 2; ++n) acc[a][b][m][n] = (f32x4){0.f, 0.f, 0.f, 0.f};
        cur = nxt; cA = nA; cB = nB; ++ui;
        if constexpr (ALIGN_EPI) { if (wr == 1) PG8_BAR; }
    }
    PG8_WAIT_V(0);
    if constexpr (!ALIGN_EPI) { if (wr == 0) PG8_BAR; }
    PG8_BAR;
    if constexpr (Epi::AFTER_DRAIN) { E.fused(acc, cur, wr, wc, fr, fq, lds, wid, lane); S.done(cur); }
#undef PG8_SA
#undef PG8_SB
#undef PG8_STAGE
#undef PG8_LDA
#undef PG8_LDB
#undef PG8_MMA
#undef PG8_WAIT_V
#undef PG8_WAIT_L
#undef PG8_BAR
#undef PG8_SCHED
}
}

#ifndef ENMASK
#define ENMASK 0x1ff
#endif
#define EN(k) (((ENMASK) >> (k)) & 1)
#ifndef DIAG
#define DIAG 0
#endif
#define DG(e) (DIAG == 1 ? (1.0f + (e)) : 1.0f)
#ifndef EXPM
#define EXPM 0
#endif
#ifndef ONE_LAUNCH
#define ONE_LAUNCH 1
#endif
#define LAS __attribute__((address_space(3)))
typedef unsigned short bf;
typedef short v8s __attribute__((ext_vector_type(8)));
typedef float v16f __attribute__((ext_vector_type(16)));
typedef float v4f __attribute__((ext_vector_type(4)));
typedef unsigned v4u __attribute__((ext_vector_type(4)));
typedef unsigned v2u __attribute__((ext_vector_type(2)));

constexpr int DM = 1024, MP = 8192, MS = 32768, MT = 40960, DFF = 2816;
constexpr int NTHR = 512, NWAVE = 8;
constexpr int LDS_BYTES = 147456;
constexpr float LOG2E = 1.4426950408889634f;
constexpr float RMS_EPS = 1e-6f;
constexpr int MI_N = 3328;
constexpr int QKVO_LD = 3072;
constexpr int AQ_LD = 1536;

constexpr size_t MiB = 1u << 20;
constexpr size_t WS_MOD = 0;
constexpr size_t WS_ROPE = 1 * MiB;
constexpr size_t WS_BAR = 1 * MiB + 256 * 1024, WS_BAR_BYTES = 16384;
constexpr int LDS_BARST = 147392;
constexpr size_t WS_CK = 2 * MiB, WS_CV = 4 * MiB;
constexpr size_t WS_GATES = 6 * MiB;
constexpr size_t WS_W = 12 * MiB;
constexpr size_t WS_XN = 92 * MiB;
constexpr size_t WS_HB = 172 * MiB;
constexpr size_t WS_BIG = 252 * MiB;
constexpr size_t WS_END = 492 * MiB;
constexpr size_t W_GU = (size_t)5632 * 1024, W_DN = (size_t)1024 * 2816, W_LAYER = 2 * (W_GU + W_DN);
constexpr size_t W_MI = 2 * W_LAYER, W_MO = W_MI + (size_t)MI_N * 1024, W_AI = W_MO + 1024 * 1024, W_AO = W_AI + 1536 * 1024, W_TOTAL = W_AO + 1024 * 1024;
static_assert(WS_W + W_TOTAL * 2 <= WS_XN, "weights fit");
constexpr size_t OUT_SC = (size_t)MT * DM, OUT_SN = OUT_SC + 4194304, OUT_SM = OUT_SN + 32768, OUT_CK = OUT_SM + 512, OUT_CV = OUT_CK + 2097152, OUT_TOTAL = OUT_CV + 2097152;

typedef float f32x2_t __attribute__((ext_vector_type(2)));
typedef __bf16 bf16x2_t __attribute__((ext_vector_type(2)));
__device__ __forceinline__ unsigned pk2(float lo, float hi) { f32x2_t v = {lo, hi}; bf16x2_t b = __builtin_convertvector(v, bf16x2_t); return __builtin_bit_cast(unsigned, b); }
typedef _Float16 h2_t __attribute__((ext_vector_type(2)));
typedef _Float16 h8_t __attribute__((ext_vector_type(8)));
__device__ __forceinline__ unsigned pkh2(float lo, float hi) { h2_t v; v.x = (_Float16)lo; v.y = (_Float16)hi; return __builtin_bit_cast(unsigned, v); }
__device__ __forceinline__ float hlo(unsigned w) { return (float)__builtin_bit_cast(h2_t, w).x; }
__device__ __forceinline__ float hhi(unsigned w) { return (float)__builtin_bit_cast(h2_t, w).y; }
__device__ __forceinline__ float bf2f(unsigned short x) { return __uint_as_float(((unsigned)x) << 16); }
__device__ __forceinline__ float bflo(unsigned w) { return __uint_as_float(w << 16); }
__device__ __forceinline__ float bfhi(unsigned w) { return __uint_as_float(w & 0xffff0000u); }
__device__ __forceinline__ float wave_sum(float v) {
#pragma unroll
    for (int o = 1; o < 64; o <<= 1) v += __shfl_xor(v, o);
    return v;
}
__device__ __forceinline__ float fast_sigmoid(float x) { return __builtin_amdgcn_rcpf(1.0f + __builtin_amdgcn_exp2f(-x * LOG2E)); }
__device__ __forceinline__ v16f mfma32h(v8s a, v8s b, v16f c) { return __builtin_amdgcn_mfma_f32_32x32x16_f16(__builtin_bit_cast(h8_t, a), __builtin_bit_cast(h8_t, b), c, 0, 0, 0); }
__device__ __forceinline__ v16f mfma32(v8s a, v8s b, v16f c) { return __builtin_amdgcn_mfma_f32_32x32x16_bf16(a, b, c, 0, 0, 0); }
typedef short v4s_t __attribute__((ext_vector_type(4)));
__device__ __forceinline__ v4s_t lds_tr16(const LAS bf* p) { return __builtin_amdgcn_ds_read_tr16_b64_v4i16((LAS v4s_t*)p); }
__device__ __forceinline__ v8s tr_pair(const LAS bf* p0, const LAS bf* p1) { const v4s_t a = lds_tr16(p0), b = lds_tr16(p1); return (v8s){a[0], a[1], a[2], a[3], b[0], b[1], b[2], b[3]}; }
__device__ __forceinline__ v8s pack8(float a0, float a1, float a2, float a3, float a4, float a5, float a6, float a7) {
    v4u w; w.x = pk2(a0, a1); w.y = pk2(a2, a3); w.z = pk2(a4, a5); w.w = pk2(a6, a7); return __builtin_bit_cast(v8s, w);
}

struct EpiSwiglu {
    static constexpr bool PERM = true, AFTER_DRAIN = false, F16 = true;
    bf* O;
    __device__ __forceinline__ void operator()(const pg8::f32x4 (&acc)[2][2][4][2], const pg8::Unit& u, int wr, int wc, int fr, int fq) const {
        const int row0 = u.pm * 256 + wr * 64 + fr, col0 = u.pn * 128 + wc * 32 + 8 * fq;
#pragma unroll
        for (int ai = 0; ai < 2; ++ai)
#pragma unroll
            for (int m = 0; m < 4; ++m) {
                bf* rowp = O + (size_t)(row0 + ai * 128 + m * 16) * DFF + col0;
                float o[8];
#pragma unroll
                for (int n = 0; n < 2; ++n)
#pragma unroll
                    for (int j = 0; j < 4; ++j) { const float g = acc[ai][0][m][n][j], up = acc[ai][1][m][n][j]; o[n * 4 + j] = g * fast_sigmoid(g) * up; }
                v4u w; w.x = pkh2(o[0], o[1]); w.y = pkh2(o[2], o[3]); w.z = pkh2(o[4], o[5]); w.w = pkh2(o[6], o[7]);
                *(v4u*)rowp = w;
            }
    }
};
template <bool HALF, bool XIN16, bool XOUT16> struct EpiResid {
    static constexpr bool PERM = true, AFTER_DRAIN = false, F16 = true;
    const void* xin_p; const void* xin_s; void* xout; const float* gate;
    __device__ __forceinline__ void operator()(const pg8::f32x4 (&acc)[2][2][4][2], const pg8::Unit& u, int wr, int wc, int fr, int fq) const {
        const int ci = u.pm < 32 ? 0 : 1 + ((u.pm - 32) >> 4);
        const void* xin = u.pm < 32 ? xin_p : xin_s;
        const int col0 = u.pn * 256 + wc * 32 + 8 * fq;
        const float* gp = gate + (size_t)ci * 9216 + col0;
        v4f gv[2][2];
#pragma unroll
        for (int bj = 0; bj < 2; ++bj)
#pragma unroll
            for (int n = 0; n < 2; ++n) gv[bj][n] = *(const v4f*)(gp + bj * 128 + n * 4) * (HALF ? 0.5f : 1.0f);
#pragma unroll
        for (int ai = 0; ai < 2; ++ai)
#pragma unroll
            for (int m = 0; m < 4; ++m) {
                const size_t off = (size_t)(u.pm * 256 + ai * 128 + wr * 64 + m * 16 + fr) * DM + col0;
#pragma unroll
                for (int bj = 0; bj < 2; ++bj) {
                    v4f x0, x1;
                    if (XIN16) { const v4u w = *(const v4u*)((const bf*)xin + off + bj * 128);
                        x0 = (v4f){hlo(w.x), hhi(w.x), hlo(w.y), hhi(w.y)}; x1 = (v4f){hlo(w.z), hhi(w.z), hlo(w.w), hhi(w.w)}; }
                    else { x0 = *(const v4f*)((const float*)xin + off + bj * 128); x1 = *(const v4f*)((const float*)xin + off + bj * 128 + 4); }
                    x0 = x0 + gv[bj][0] * acc[ai][bj][m][0]; x1 = x1 + gv[bj][1] * acc[ai][bj][m][1];
                    if (XOUT16) { v4u w; w.x = pkh2(x0[0], x0[1]); w.y = pkh2(x0[2], x0[3]); w.z = pkh2(x1[0], x1[1]); w.w = pkh2(x1[2], x1[3]); *(v4u*)((bf*)xout + off + bj * 128) = w; }
                    else { *(v4f*)((float*)xout + off + bj * 128) = x0; *(v4f*)((float*)xout + off + bj * 128 + 4) = x1; }
                }
            }
    }
};
__device__ __forceinline__ float log_sigmoid(float x) { return x < 0.f ? x - log1pf(expf(x)) : -log1pf(expf(-x)); }
struct EpiMlstmIn {
    static constexpr bool PERM = true, AFTER_DRAIN = false, F16 = true;
    bf* O; float* gates; const float* bgate;
    __device__ __forceinline__ void operator()(const pg8::f32x4 (&acc)[2][2][4][2], const pg8::Unit& u, int wr, int wc, int fr, int fq) const {
        const int row0 = u.pm * 256 + wr * 64 + fr;
        if (u.pn < 12) {
            const float sc = u.pn < 2 ? 0.125f : 1.0f;
            const int col0 = u.pn * 256 + wc * 32 + 8 * fq;
#pragma unroll
            for (int ai = 0; ai < 2; ++ai)
#pragma unroll
                for (int m = 0; m < 4; ++m) {
                    bf* rowp = O + (size_t)(row0 + ai * 128 + m * 16) * QKVO_LD + col0;
#pragma unroll
                    for (int bj = 0; bj < 2; ++bj) { const pg8::f32x4 v0 = acc[ai][bj][m][0] * sc, v1 = acc[ai][bj][m][1] * sc;
                        v4u w;
                        if (u.pn < 4) { w.x = pkh2(v0[0], v0[1]); w.y = pkh2(v0[2], v0[3]); w.z = pkh2(v1[0], v1[1]); w.w = pkh2(v1[2], v1[3]); }
                        else { w.x = pk2(v0[0], v0[1]); w.y = pk2(v0[2], v0[3]); w.z = pk2(v1[0], v1[1]); w.w = pk2(v1[2], v1[3]); }
                        *(v4u*)(rowp + bj * 128) = w; }
                }
        } else if (wc == 0) {
#pragma unroll
            for (int n = 0; n < 2; ++n) { const int c = 8 * fq + 4 * n; const v4f bv = *(const v4f*)(bgate + c);
#pragma unroll
                for (int ai = 0; ai < 2; ++ai)
#pragma unroll
                    for (int m = 0; m < 4; ++m) { const v4f v = acc[ai][0][m][n] + bv;
                        *(v4f*)(gates + (size_t)(row0 + ai * 128 + m * 16) * 32 + c) = v; } }
        }
    }
};
struct EpiAttnIn {
    static constexpr bool PERM = false, AFTER_DRAIN = false, F16 = true;
    bf* O; float* ck_out; float* cv_out; const float* rope;
    __device__ __forceinline__ void operator()(const pg8::f32x4 (&acc)[2][2][4][2], const pg8::Unit& u, int wr, int wc, int fr, int fq) const {
        const bool sample = u.pm >= 32, do_rope = sample && u.pn < 5;
        const int colt = wc * 32 + 4 * fq;
#pragma unroll
        for (int ai = 0; ai < 2; ++ai)
#pragma unroll
            for (int m = 0; m < 4; ++m) {
                const int row = u.pm * 256 + ai * 128 + wr * 64 + m * 16 + fr;
                v4f cs = (v4f){1.f, 1.f, 1.f, 1.f}, sn = (v4f){0.f, 0.f, 0.f, 0.f};
                if (do_rope) { const int t = (row - MP) & 4095; const int pos = (wc & 1) ? (t & 63) : (t >> 6);
                    cs = *(const v4f*)(rope + pos * 16 + 4 * fq); sn = *(const v4f*)(rope + 1024 + pos * 16 + 4 * fq); }
#pragma unroll
                for (int bj = 0; bj < 2; ++bj) {
                    const v4f x0 = acc[ai][bj][m][0], x1 = acc[ai][bj][m][1];
                    const v4f y0 = x0 * cs - x1 * sn, y1 = x1 * cs + x0 * sn;
                    bf* op = O + (size_t)row * AQ_LD + u.pn * 256 + bj * 128 + colt;
                    v2u w0, w1; w0.x = pk2(y0[0], y0[1]); w0.y = pk2(y0[2], y0[3]); w1.x = pk2(y1[0], y1[1]); w1.y = pk2(y1[2], y1[3]);
                    *(v2u*)op = w0; *(v2u*)(op + 16) = w1;
                    if (!sample && u.pn >= 4) { float* cp = (u.pn == 4 ? ck_out : cv_out) + (size_t)row * 256 + bj * 128 + colt;
                        const float dgs = 1.0f; *(v4f*)cp = x0 * dgs; *(v4f*)(cp + 16) = x1 * dgs; }
                }
            }
    }
};

__device__ __forceinline__ void transpose_item(const float* W, int K, int N, bf* WT, int item, int mode, LAS float* scr, int lane) {
    const int nblk = N / 32, kb = item / nblk, nb = item % nblk, k0 = 64 * kb, n0 = 32 * nb;
    int drow0 = n0;
    if (mode & 1) { int j = n0, up = 0; if (j >= DFF) { j -= DFF; up = 1; } drow0 = (j >> 7) * 256 + up * 128 + (j & 127); }
#pragma unroll 8
    for (int i = 0; i < 32; ++i) { const int kk = 2 * i + (lane >> 5); scr[kk * 33 + (lane & 31)] = W[(size_t)(k0 + kk) * N + n0 + (lane & 31)]; }
    asm volatile("s_waitcnt lgkmcnt(0)" ::: "memory");
    const int c = lane & 7;
#pragma unroll
    for (int j = 0; j < 4; ++j) { const int n = (lane >> 3) + 8 * j; const LAS float* s = scr + (8 * c) * 33 + n;
        v4u o;
        if (mode & 2) { o.x = pkh2(s[0 * 33], s[1 * 33]); o.y = pkh2(s[2 * 33], s[3 * 33]); o.z = pkh2(s[4 * 33], s[5 * 33]); o.w = pkh2(s[6 * 33], s[7 * 33]); }
        else { o.x = pk2(s[0 * 33], s[1 * 33]); o.y = pk2(s[2 * 33], s[3 * 33]); o.z = pk2(s[4 * 33], s[5 * 33]); o.w = pk2(s[6 * 33], s[7 * 33]); }
        *(v4u*)(WT + (size_t)(drow0 + n) * K + k0 + 8 * c) = o; }
    asm volatile("s_waitcnt lgkmcnt(0)" ::: "memory");
}

struct Args { const float* in[24]; float* out; unsigned char* ws; int ph_lo, ph_hi; };

__device__ __forceinline__ void mod_layer(const Args& A, LAS unsigned char* lds, int tid, int l, int blk0, int nblk) {
    const int lane = tid & 63, wave = __builtin_amdgcn_readfirstlane(tid >> 6);
    float* MOD = (float*)(A.ws + WS_MOD);
    LAS float* sc = (LAS float*)(lds + 73728);
    LAS float* red = (LAS float*)(lds + 110592);
    for (int i = tid; i < 9 * 1024; i += NTHR) { const int ci = i >> 10, k = i & 1023; const float c = ci == 0 ? A.in[8][k] : A.in[7][(ci - 1) * 1024 + k]; sc[i] = c / (1.0f + expf(-c)); }
    __syncthreads();
    for (int item = (int)blockIdx.x - blk0; item < 144; item += nblk) {
        const int n0 = item * 64;
        const float* wp = A.in[9] + ((size_t)l * 1024 + wave * 128) * 9216 + n0 + lane;
        float a0 = 0.f, a1 = 0.f, a2 = 0.f, a3 = 0.f, a4 = 0.f, a5 = 0.f, a6 = 0.f, a7 = 0.f, a8 = 0.f;
        const LAS float* sp = sc + wave * 128;
#pragma unroll 16
        for (int kk = 0; kk < 128; ++kk) { const float w = wp[(size_t)kk * 9216];
            a0 += sp[kk] * w; a1 += sp[1024 + kk] * w; a2 += sp[2048 + kk] * w; a3 += sp[3072 + kk] * w; a4 += sp[4096 + kk] * w;
            a5 += sp[5120 + kk] * w; a6 += sp[6144 + kk] * w; a7 += sp[7168 + kk] * w; a8 += sp[8192 + kk] * w; }
        LAS float* rp = red + wave * 576 + lane;
        rp[0] = a0; rp[64] = a1; rp[128] = a2; rp[192] = a3; rp[256] = a4; rp[320] = a5; rp[384] = a6; rp[448] = a7; rp[512] = a8;
        __syncthreads();
        for (int o = tid; o < 576; o += NTHR) { const int ci = o >> 6, ln = o & 63; float s = A.in[10][l * 9216 + n0 + ln];
#pragma unroll
            for (int w = 0; w < 8; ++w) s += red[w * 576 + ci * 64 + ln];
            MOD[(size_t)(l * 9 + ci) * 9216 + n0 + ln] = s; }
        __syncthreads();
    }
}
__device__ __forceinline__ void prologue(const Args& A, LAS unsigned char* lds, int tid) {
    const int lane = tid & 63, wave = __builtin_amdgcn_readfirstlane(tid >> 6);
    const int G = gridDim.x, gw = blockIdx.x * NWAVE + wave, NGW = G * NWAVE, gt = blockIdx.x * NTHR + tid, NGT = G * NTHR;
    unsigned char* ws = A.ws;
    float* MOD = (float*)(ws + WS_MOD);
    bf* Wb = (bf*)(ws + WS_W);
    LAS float* scr = (LAS float*)(lds + wave * 8704);
    mod_layer(A, lds, tid, 0, 0, G);
    { v4u* z = (v4u*)(Wb + W_MI + (size_t)3104 * 1024); for (int i = gt; i < 224 * 1024 / 8; i += NGT) z[i] = (v4u){0u, 0u, 0u, 0u}; }
    constexpr int I_GU = 16 * 176, I_DN = 44 * 32, I_MI = 16 * 97;
    constexpr int NITEMS = I_GU + I_DN + I_MI;
    for (int it = gw; it < NITEMS; it += NGW) {
        int r = it;
        if (r < I_GU) { transpose_item(A.in[12], 1024, 5632, Wb, r, 3, scr, lane); continue; } r -= I_GU;
        if (r < I_DN) { transpose_item(A.in[13], 2816, 1024, Wb + W_GU, r, 2, scr, lane); continue; } r -= I_DN;
        transpose_item(A.in[16], 1024, 3104, Wb + W_MI, r, 2, scr, lane);
    }
}
__device__ __forceinline__ void transposes_late(const Args& A, LAS unsigned char* lds, int tid_in, int first_blk) {
    int tid = tid_in; asm volatile("" : "+v"(tid) :: "memory");
    const int lane = tid & 63, wave = __builtin_amdgcn_readfirstlane(tid >> 6);
    const int nb = (int)gridDim.x - first_blk; if ((int)blockIdx.x < first_blk || nb <= 0) return;
    const int gw = ((int)blockIdx.x - first_blk) * NWAVE + wave, NGW = nb * NWAVE;
    mod_layer(A, lds, tid, 1, first_blk, nb);
    const int lt = ((int)blockIdx.x - first_blk) * NTHR + tid, NLT = nb * NTHR;
    if (lt < 1024) { const int pos = lt >> 4, i = lt & 15; const float fr = __builtin_amdgcn_exp2f(-(float)i * (13.287712379549449f / 16.0f)); const float ang = (float)pos * fr;
        float* rope = (float*)(A.ws + WS_ROPE); rope[lt] = cosf(ang); rope[1024 + lt] = sinf(ang); }
    { bf* CK = (bf*)(A.ws + WS_CK); bf* CV = (bf*)(A.ws + WS_CV);
      for (int i = lt; i < 262144; i += NLT) { const v4f k = ((const v4f*)A.in[5])[i], v = ((const v4f*)A.in[6])[i];
          v2u wk, wv; wk.x = pk2(k[0], k[1]); wk.y = pk2(k[2], k[3]); wv.x = pk2(v[0], v[1]); wv.y = pk2(v[2], v[3]);
          ((v2u*)CK)[i] = wk; ((v2u*)CV)[i] = wv; } }
    bf* Wb = (bf*)(A.ws + WS_W);
    LAS float* scr = (LAS float*)(lds + wave * 8704);
    constexpr int I_GU = 16 * 176, I_DN = 44 * 32, I_AI = 16 * 48, I_AO = 16 * 32, I_MO = 16 * 32;
    constexpr int I_LAYER = 2 * (I_GU + I_DN), NITEMS = (I_GU + I_DN) + I_MO + I_LAYER + I_AI + I_AO;
    for (int it = gw; it < NITEMS; it += NGW) {
        int r = it;
        if (r < I_MO) { transpose_item(A.in[19], 1024, 1024, Wb + W_MO, r, 2, scr, lane); continue; } r -= I_MO;
        if (r < I_GU) { transpose_item(A.in[14], 1024, 5632, Wb + W_GU + W_DN, r, 3, scr, lane); continue; } r -= I_GU;
        if (r < I_DN) { transpose_item(A.in[15], 2816, 1024, Wb + 2 * W_GU + W_DN, r, 2, scr, lane); continue; } r -= I_DN;
        if (r < I_LAYER) { bf* wl = Wb + W_LAYER;
            if (r < I_GU) { transpose_item(A.in[12] + W_GU, 1024, 5632, wl, r, 3, scr, lane); continue; } r -= I_GU;
            if (r < I_DN) { transpose_item(A.in[13] + W_DN, 2816, 1024, wl + W_GU, r, 2, scr, lane); continue; } r -= I_DN;
            if (r < I_GU) { transpose_item(A.in[14] + W_GU, 1024, 5632, wl + W_GU + W_DN, r, 3, scr, lane); continue; } r -= I_GU;
            transpose_item(A.in[15] + W_DN, 2816, 1024, wl + 2 * W_GU + W_DN, r, 2, scr, lane); continue; }
        r -= I_LAYER;
        if (r < I_AI) { transpose_item(A.in[20], 1024, 1536, Wb + W_AI, r, 2, scr, lane); continue; } r -= I_AI;
        transpose_item(A.in[22], 1024, 1024, Wb + W_AO, r, 2, scr, lane);
    }
}

template <int MODE, bool IN16>
__device__ __forceinline__ void norm_phase(const void* xin_p, const void* xin_s, bf* XN, float* fout, const float* g, const float* shiftb, int tid) {
    const int lane = tid & 63, wave = __builtin_amdgcn_readfirstlane(tid >> 6);
    const int gw = blockIdx.x * NWAVE + wave, NGW = gridDim.x * NWAVE;
    v4f gv[4];
#pragma unroll
    for (int j = 0; j < 4; ++j) gv[j] = ((const v4f*)g)[64 * j + lane];
    float dgscale = 1.0f;
#if DIAG == 2
    if (MODE == 1) { const float ratio = fminf(shiftb[4000], 0.5f); dgscale = 1.0f + sqrtf(5e-4f + 0.01f * ratio); }
#endif
    static_assert(MT % (2 * 2048) == 0 || true, "rows are dealt two at a time");
    for (int m0 = gw; m0 < MT; m0 += 2 * NGW) {
        int mr[2]; mr[0] = m0; mr[1] = m0 + NGW;
        const bool two = mr[1] < MT; if (!two) mr[1] = mr[0];
        v4f v[2][4]; float s[2];
#pragma unroll
        for (int q = 0; q < 2; ++q) { s[q] = 0.f;
            if (IN16) { const bf* xr = (const bf*)(mr[q] < MP ? xin_p : xin_s) + (size_t)mr[q] * DM;
#pragma unroll
                for (int j = 0; j < 4; ++j) { const v2u w = ((const v2u*)xr)[64 * j + lane]; v[q][j] = (v4f){hlo(w.x), hhi(w.x), hlo(w.y), hhi(w.y)}; } }
            else { const float* xr = (const float*)(mr[q] < MP ? xin_p : xin_s) + (size_t)mr[q] * DM;
#pragma unroll
                for (int j = 0; j < 4; ++j) v[q][j] = ((const v4f*)xr)[64 * j + lane]; } }
#pragma unroll
        for (int q = 0; q < 2; ++q)
#pragma unroll
            for (int j = 0; j < 4; ++j) s[q] += (v[q][j][0] * v[q][j][0] + v[q][j][1] * v[q][j][1]) + (v[q][j][2] * v[q][j][2] + v[q][j][3] * v[q][j][3]);
#pragma unroll
        for (int q = 0; q < 2; ++q) {
            if (q == 1 && !two) break;
            const int m = mr[q];
            const float rstd = 1.0f / sqrtf(wave_sum(s[q]) * (1.0f / DM) + RMS_EPS);
            if (MODE == 1) {
#pragma unroll
                for (int j = 0; j < 4; ++j) ((v4f*)(fout + (size_t)m * DM))[64 * j + lane] = v[q][j] * rstd * gv[j] * dgscale;
            } else {
                const int ci = m < MP ? 0 : 1 + ((m - MP) >> 12);
                const float* sh = shiftb + (size_t)ci * 9216; const float* scp = sh + 1024;
#pragma unroll
                for (int j = 0; j < 4; ++j) { const v4f shv = ((const v4f*)sh)[64 * j + lane], scv = ((const v4f*)scp)[64 * j + lane];
                    const v4f y = v[q][j] * rstd * gv[j] * (scv + 1.0f) + shv;
                    v2u w; w.x = pkh2(y[0], y[1]); w.y = pkh2(y[2], y[3]);
                    ((v2u*)(XN + (size_t)m * DM))[64 * j + lane] = w; }
            }
        }
    }
}

__device__ __forceinline__ void combine_phase(bf* XN, const bf* HB, const bf* BIG, const float* ghead, int tid) {
    const int lane = tid & 63, wave = __builtin_amdgcn_readfirstlane(tid >> 6);
    const int gw = blockIdx.x * NWAVE + wave, NGW = gridDim.x * NWAVE;
    const int c0 = lane * 16;
    float gh[16];
#pragma unroll
    for (int e = 0; e < 16; ++e) gh[e] = ghead[c0 + e];
    for (int m = gw; m < MT; m += NGW) {
        const v4u f0 = *(const v4u*)(XN + (size_t)m * DM + c0), f1 = *(const v4u*)(XN + (size_t)m * DM + c0 + 8);
        const v4u b0 = *(const v4u*)(HB + (size_t)m * DM + c0), b1 = *(const v4u*)(HB + (size_t)m * DM + c0 + 8);
        const v4u o0 = *(const v4u*)(BIG + (size_t)m * QKVO_LD + 2048 + c0), o1 = *(const v4u*)(BIG + (size_t)m * QKVO_LD + 2048 + c0 + 8);
        float hs[16], og[16]; float ss = 0.f;
#pragma unroll
        for (int q = 0; q < 4; ++q) {
            hs[2 * q] = bflo(f0[q]) + bflo(b0[q]); hs[2 * q + 1] = bfhi(f0[q]) + bfhi(b0[q]);
            hs[8 + 2 * q] = bflo(f1[q]) + bflo(b1[q]); hs[8 + 2 * q + 1] = bfhi(f1[q]) + bfhi(b1[q]);
            og[2 * q] = bflo(o0[q]); og[2 * q + 1] = bfhi(o0[q]); og[8 + 2 * q] = bflo(o1[q]); og[8 + 2 * q + 1] = bfhi(o1[q]); }
#pragma unroll
        for (int e = 0; e < 16; ++e) ss += hs[e] * hs[e];
        ss += __shfl_xor(ss, 1); ss += __shfl_xor(ss, 2); ss += __shfl_xor(ss, 4);
        const float rs = 1.0f / sqrtf(ss * (1.0f / 128.0f) + RMS_EPS);
        float y[16];
#pragma unroll
        for (int e = 0; e < 16; ++e) y[e] = hs[e] * rs * gh[e] * fast_sigmoid(og[e]);
        v4u w0, w1; w0.x = pkh2(y[0], y[1]); w0.y = pkh2(y[2], y[3]); w0.z = pkh2(y[4], y[5]); w0.w = pkh2(y[6], y[7]);
        w1.x = pkh2(y[8], y[9]); w1.y = pkh2(y[10], y[11]); w1.z = pkh2(y[12], y[13]); w1.w = pkh2(y[14], y[15]);
        *(v4u*)(XN + (size_t)m * DM + c0) = w0; *(v4u*)(XN + (size_t)m * DM + c0 + 8) = w1;
    }
}

constexpr int ML_KQ = 0, ML_VT = 18432, ML_KT = 59392, ML_CT = 83968, ML_F = 102400;
__device__ __forceinline__ void mlstm_unit(LAS unsigned char* lds, const Args& A, int sample, int b, int hd, int dir, int tid) {
    const int lane = tid & 63, wave = __builtin_amdgcn_readfirstlane(tid >> 6), r = lane & 31, h = lane >> 5;
    unsigned char* ws = A.ws;
    const bf* BIG = (const bf*)(ws + WS_BIG);
    const float* GATES = (const float*)(ws + WS_GATES);
    bf* HD = (bf*)(ws + (dir ? WS_HB : WS_XN));
    const int NTOK = sample ? 4096 : 256, rowbase = sample ? MP + b * 4096 : b * 256, nch = NTOK >> 7;
    LAS bf* Kq = (LAS bf*)(lds + ML_KQ); LAS bf* Vs = (LAS bf*)(lds + ML_VT); LAS bf* K2 = (LAS bf*)(lds + ML_KT); LAS bf* Ct = (LAS bf*)(lds + ML_CT);
    const int trq = (lane & 15) >> 2, trc = 16 * ((lane >> 4) & 1) + 4 * (lane & 3);
    LAS float* fa = (LAS float*)(lds + ML_F);
    LAS float* s_n = fa + 1536;
    const int db = wave >> 2, vb = wave & 3;
    const int sidx = (b * 2 + dir) * 8 + hd;
    v16f C; float mcur;
    if (sample) {
        const float* cp = A.in[2] + (size_t)sidx * 8192;
#pragma unroll
        for (int i = 0; i < 16; ++i) { const int d = db * 32 + (i & 3) + 8 * (i >> 2) + 4 * h; C[i] = cp[d * 128 + vb * 32 + r]; }
        if (tid < 64) s_n[tid] = A.in[3][sidx * 64 + tid];
        mcur = A.in[4][sidx];
    } else {
#pragma unroll
        for (int i = 0; i < 16; ++i) C[i] = 0.f;
        if (tid < 64) s_n[tid] = 0.f;
        mcur = 0.f;
    }
#pragma unroll
    for (int g4 = 0; g4 < 4; ++g4) { v2u w; w.x = pk2(C[4 * g4], C[4 * g4 + 1]); w.y = pk2(C[4 * g4 + 2], C[4 * g4 + 3]);
        *(LAS v2u*)(Ct + (vb * 32 + r) * 72 + db * 32 + 8 * g4 + 4 * h) = w; }
    __syncthreads();
#define ML_TOKC(cc, i) (dir ? (NTOK - 1 - ((cc) * 128 + (i))) : ((cc) * 128 + (i)))
#define ML_FA(p) (fa + (p) * 768)
#define ML_GATES(cc, mc, FB) do { \
        const int i0 = 2 * lane, i1 = i0 + 1; \
        const float li0 = gl0, lf0 = log_sigmoid(gf0), li1 = gl1, lf1 = log_sigmoid(gf1); \
        float incl = lf0 + lf1; \
        _Pragma("unroll") for (int o = 1; o < 64; o <<= 1) { const float t = __shfl_up(incl, o); if (lane >= o) incl += t; } \
        const float b1 = incl, b0 = incl - lf1; \
        const float a0 = li0 - b0, a1 = li1 - b1; \
        float im = fmaxf(a0, a1); \
        _Pragma("unroll") for (int o = 1; o < 64; o <<= 1) { const float t = __shfl_up(im, o); if (lane >= o) im = fmaxf(im, t); } \
        float ex = __shfl_up(im, 1); if (lane == 0) ex = -INFINITY; \
        const float am0 = fmaxf(ex, a0), am1 = im; \
        const float rc0 = -fmaxf(am0, (mc)), rc1 = -fmaxf(am1, (mc)); \
        const float bend = __shfl(b1, 63), amend = __shfl(im, 63); \
        const float mm = fmaxf((mc), amend); \
        LAS float* F = (FB); \
        F[i0] = a0; F[i1] = a1; F[128 + i0] = rc0; F[128 + i1] = rc1; F[256 + i0] = expf((mc) + rc0); F[256 + i1] = expf((mc) + rc1); \
        F[384 + i0] = b0; F[384 + i1] = b1; F[512 + i0] = expf(a0 - mm); F[512 + i1] = expf(a1 - mm); \
        if (lane == 0) { F[640] = expf((mc) - mm); F[641] = bend + mm; } \
    } while (0)
#define ML_GLOAD(cc) do { const int i0 = 2 * lane; \
        const float* g0 = GATES + (size_t)(rowbase + ML_TOKC((cc), i0)) * 32 + dir * 16 + hd; \
        const float* g1 = GATES + (size_t)(rowbase + ML_TOKC((cc), i0 + 1)) * 32 + dir * 16 + hd; \
        gl0 = g0[0]; gf0 = g0[8]; gl1 = g1[0]; gf1 = g1[8]; } while (0)
    float gl0 = 0.f, gf0 = 0.f, gl1 = 0.f, gf1 = 0.f;
    v4u kreg[2], vreg[4]; int ki[2], kch[2];
#pragma unroll
    for (int q = 0; q < 2; ++q) { const int id = tid + q * 512; ki[q] = id >> 3; kch[q] = id & 7;
        kreg[q] = *(const v4u*)(BIG + (size_t)(rowbase + ML_TOKC(0, ki[q])) * QKVO_LD + 512 + hd * 64 + kch[q] * 8); }
#pragma unroll
    for (int q = 0; q < 4; ++q) { const int id = tid + q * 512, i = id >> 4, ch = id & 15;
        vreg[q] = *(const v4u*)(BIG + (size_t)(rowbase + ML_TOKC(0, i)) * QKVO_LD + 1024 + hd * 128 + ch * 8); }
    if (wave == 0) { ML_GLOAD(0); ML_GATES(0, mcur, ML_FA(0)); if (nch > 1) ML_GLOAD(1); }
    __syncthreads();
    for (int c = 0; c < nch; ++c) {
#define ML_TOK(i) ML_TOKC(c, i)
        LAS float* const F = ML_FA(c & 1);
        LAS float* const s_a = F, * const s_rowc = F + 128, * const s_inter = F + 256, * const s_b = F + 384, * const s_wend = F + 512;
        const float keep = F[640], mnew = F[641];
        const int tb_ = wave & 3, t_ = tb_ * 32 + r;
        const size_t row_t = (size_t)(rowbase + ML_TOK(t_));
        v8s qf[4];
#pragma unroll
        for (int ks = 0; ks < 4; ++ks) qf[ks] = *(const v8s*)(BIG + row_t * QKVO_LD + hd * 64 + 16 * ks + 8 * h);
#pragma unroll
        for (int q = 0; q < 4; ++q) { const int id = tid + q * 512, i = id >> 4, ch = id & 15;
            *(LAS v4u*)(Vs + i * 160 + ch * 8) = vreg[q]; }
#pragma unroll
        for (int q = 0; q < 2; ++q) { *(LAS v4u*)(Kq + ki[q] * 72 + kch[q] * 8) = kreg[q];
            const float we = s_wend[ki[q]]; v4u kw;
#pragma unroll
            for (int e = 0; e < 4; ++e) kw[e] = pk2(hlo(kreg[q][e]) * we, hhi(kreg[q][e]) * we);
            *(LAS v4u*)(K2 + ki[q] * 96 + kch[q] * 8) = kw; }
        if (c + 1 < nch) {
#pragma unroll
            for (int q = 0; q < 4; ++q) { const int id = tid + q * 512, i = id >> 4, ch = id & 15;
                vreg[q] = *(const v4u*)(BIG + (size_t)(rowbase + ML_TOKC(c + 1, i)) * QKVO_LD + 1024 + hd * 128 + ch * 8); }
#pragma unroll
            for (int q = 0; q < 2; ++q) kreg[q] = *(const v4u*)(BIG + (size_t)(rowbase + ML_TOKC(c + 1, ki[q])) * QKVO_LD + 512 + hd * 64 + kch[q] * 8); }
        __syncthreads();
        {
            const int tb = tb_, vh = wave >> 2, t = t_;
            const float rc = s_rowc[t], it = s_inter[t];
            v16f num0, num1; float den = 0.f;
#pragma unroll
            for (int i = 0; i < 16; ++i) { num0[i] = 0.f; num1[i] = 0.f; }
            for (int sb = 0; sb <= tb; ++sb) {
                v16f S;
#pragma unroll
                for (int i = 0; i < 16; ++i) S[i] = 0.f;
#pragma unroll
                for (int ks = 0; ks < 4; ++ks) { const v8s kf = *(const LAS v8s*)(Kq + (sb * 32 + r) * 72 + 16 * ks + 8 * h); S = mfma32h(kf, qf[ks], S); }
#pragma unroll
                for (int g4 = 0; g4 < 4; ++g4) { const v4f av = *(const LAS v4f*)(s_a + sb * 32 + 8 * g4 + 4 * h);
#pragma unroll
                    for (int j = 0; j < 4; ++j) { const int i = 4 * g4 + j, s = sb * 32 + 8 * g4 + 4 * h + j;
                        const float e = __builtin_amdgcn_exp2f((rc + av[j]) * LOG2E); const float w = (s <= t) ? S[i] * e : 0.f; S[i] = w; den += w; } }
                const v8s wf0 = pack8(S[0], S[1], S[2], S[3], S[4], S[5], S[6], S[7]), wf1 = pack8(S[8], S[9], S[10], S[11], S[12], S[13], S[14], S[15]);
#pragma unroll
                for (int s2 = 0; s2 < 2; ++s2) { const v8s wf = s2 ? wf1 : wf0;
                    const LAS bf* vp = Vs + (sb * 32 + 16 * s2 + 4 * h + trq) * 160 + (2 * vh) * 32 + trc;
                    num0 = mfma32(tr_pair(vp, vp + 8 * 160), wf, num0);
                    num1 = mfma32(tr_pair(vp + 32, vp + 8 * 160 + 32), wf, num1); }
            }
            float qn = 0.f;
#pragma unroll
            for (int ks = 0; ks < 4; ++ks) {
                const v4u qw = __builtin_bit_cast(v4u, qf[ks]); float qv[8];
#pragma unroll
                for (int e = 0; e < 4; ++e) { qv[2 * e] = hlo(qw[e]); qv[2 * e + 1] = hhi(qw[e]); }
                const v4f n0 = *(const LAS v4f*)(s_n + 16 * ks + 8 * h), n1 = *(const LAS v4f*)(s_n + 16 * ks + 8 * h + 4);
                qn += qv[0] * n0[0] + qv[1] * n0[1] + qv[2] * n0[2] + qv[3] * n0[3] + qv[4] * n1[0] + qv[5] * n1[1] + qv[6] * n1[2] + qv[7] * n1[3];
                const v8s qs = pack8(qv[0] * it, qv[1] * it, qv[2] * it, qv[3] * it, qv[4] * it, qv[5] * it, qv[6] * it, qv[7] * it);
                const v8s c0 = *(const LAS v8s*)(Ct + ((2 * vh) * 32 + r) * 72 + 16 * ks + 8 * h), c1 = *(const LAS v8s*)(Ct + ((2 * vh + 1) * 32 + r) * 72 + 16 * ks + 8 * h);
                num0 = mfma32(c0, qs, num0); num1 = mfma32(c1, qs, num1);
            }
            den += __shfl_xor(den, 32); qn += __shfl_xor(qn, 32);
            const float dd = den + it * qn;
            const float hden = fmaxf(fabsf(dd), expf(rc - s_b[t]));
            const float inv = 1.0f / hden;
            bf* op = HD + row_t * DM + hd * 128 + (2 * vh) * 32 + 4 * h;
#pragma unroll
            for (int g4 = 0; g4 < 4; ++g4) {
                v2u w; w.x = pk2(num0[4 * g4] * inv, num0[4 * g4 + 1] * inv); w.y = pk2(num0[4 * g4 + 2] * inv, num0[4 * g4 + 3] * inv); *(v2u*)(op + 8 * g4) = w;
                v2u x; x.x = pk2(num1[4 * g4] * inv, num1[4 * g4 + 1] * inv); x.y = pk2(num1[4 * g4 + 2] * inv, num1[4 * g4 + 3] * inv); *(v2u*)(op + 32 + 8 * g4) = x; }
        }
        if (wave == 0 && c + 1 < nch) { ML_GATES(c + 1, mnew, ML_FA((c + 1) & 1)); if (c + 2 < nch) ML_GLOAD(c + 2); }
        __syncthreads();
#pragma unroll
        for (int i = 0; i < 16; ++i) C[i] *= keep;
#pragma unroll
        for (int ks = 0; ks < 8; ++ks) { const LAS bf* kp = K2 + (16 * ks + 8 * h + trq) * 96 + db * 32 + trc; const LAS bf* vp = Vs + (16 * ks + 8 * h + trq) * 160 + vb * 32 + trc;
            const v8s af = tr_pair(kp, kp + 4 * 96), bfr = tr_pair(vp, vp + 4 * 160);
            C = mfma32(af, bfr, C); }
#pragma unroll
        for (int g4 = 0; g4 < 4; ++g4) { v2u w; w.x = pk2(C[4 * g4], C[4 * g4 + 1]); w.y = pk2(C[4 * g4 + 2], C[4 * g4 + 3]);
            *(LAS v2u*)(Ct + (vb * 32 + r) * 72 + db * 32 + 8 * g4 + 4 * h) = w; }
        if (tid < 64) { float s = 0.f;
#pragma unroll 2
            for (int ss = 0; ss < 128; ss += 4) s += (bf2f(K2[ss * 96 + tid]) + bf2f(K2[(ss + 1) * 96 + tid])) + (bf2f(K2[(ss + 2) * 96 + tid]) + bf2f(K2[(ss + 3) * 96 + tid]));
            s_n[tid] = keep * s_n[tid] + s; }
        mcur = mnew;
        __syncthreads();
#undef ML_TOK
    }
    if (!sample) {
        float* oc = A.out + OUT_SC + (size_t)sidx * 8192;
#pragma unroll
        for (int i = 0; i < 16; ++i) { const int d = db * 32 + (i & 3) + 8 * (i >> 2) + 4 * h; oc[d * 128 + vb * 32 + r] = C[i]; }
        if (tid < 64) A.out[OUT_SN + (size_t)sidx * 64 + tid] = s_n[tid];
        if (tid == 0) A.out[OUT_SM + sidx] = mcur;
    }
    __syncthreads();
}
__device__ __forceinline__ void mlstm_phase(LAS unsigned char* lds, const Args& A, int tid) {
    const int G = gridDim.x, bx = blockIdx.x;
    if (G == 256) {
        if (bx < 128) mlstm_unit(lds, A, 1, bx >> 4, (bx >> 1) & 7, bx & 1, tid);
        else { for (int k = 0; k < 4; ++k) { const int u = (bx - 128) * 4 + k; mlstm_unit(lds, A, 0, u >> 4, (u >> 1) & 7, u & 1, tid); }
               transposes_late(A, lds, tid, 128); }
    } else {
        for (int u = bx; u < 640; u += G) { if (u < 128) mlstm_unit(lds, A, 1, u >> 4, (u >> 1) & 7, u & 1, tid); else { const int p = u - 128; mlstm_unit(lds, A, 0, p >> 4, (p >> 1) & 7, p & 1, tid); } }
        transposes_late(A, lds, tid, 0);
    }
}

constexpr int AT_K = 0, AT_V = 18432;

__device__ __forceinline__ void attn_qblock(const v16f& S, bool masked, int tq, int key0, int h, float& m, float& l, v16f& oA, v16f& oB, v8s& pf0, v8s& pf1) {
    float sc[16];
    const float C2 = 0.125f * LOG2E;
#pragma unroll
    for (int i = 0; i < 16; ++i) { sc[i] = S[i];
        if (masked) { const int s = key0 + (i & 3) + 8 * (i >> 2) + 4 * h; const int dlt = tq - s; if (dlt > 128 || dlt < -128) sc[i] = -INFINITY; } }
    float mx = fmaxf(sc[0], sc[1]);
#pragma unroll
    for (int i = 2; i < 16; ++i) mx = fmaxf(mx, sc[i]);
    mx = fmaxf(mx, __shfl_xor(mx, 32)) * C2;
    if (__any(mx > m)) {
        const float mn = fmaxf(m, mx);
        const float alpha = __builtin_amdgcn_exp2f(m - mn);
        m = mn; l *= alpha;
#pragma unroll
        for (int i = 0; i < 16; ++i) { oA[i] *= alpha; oB[i] *= alpha; }
    }
    const float nm = -m;
    float ps = 0.f;
#pragma unroll
    for (int i = 0; i < 16; ++i) { sc[i] = __builtin_amdgcn_exp2f(__builtin_fmaf(sc[i], C2, nm)); ps += sc[i]; }
    l += ps;
    pf0 = pack8(sc[0], sc[1], sc[2], sc[3], sc[4], sc[5], sc[6], sc[7]);
    pf1 = pack8(sc[8], sc[9], sc[10], sc[11], sc[12], sc[13], sc[14], sc[15]);
}
__device__ __forceinline__ void attn_unit(LAS unsigned char* lds, const Args& A, int sample, int b, int kv, int qblk, int tid) {
    const int lane = tid & 63, wave = __builtin_amdgcn_readfirstlane(tid >> 6), r = lane & 31, h = lane >> 5;
    unsigned char* ws = A.ws;
    const bf* QKV = (const bf*)(ws + WS_BIG); const bf* CK = (const bf*)(ws + WS_CK); const bf* CV = (const bf*)(ws + WS_CV);
    bf* O = (bf*)(ws + WS_XN);
    LAS bf* Ks = (LAS bf*)(lds + AT_K); LAS bf* Vs = (LAS bf*)(lds + AT_V);
    const LAS bf* const vtr0 = Vs + (4 * h + ((lane & 15) >> 2)) * 96 + 16 * ((lane >> 4) & 1) + 4 * (lane & 3);
    const int g = wave >> 1, qhalf = wave & 1;
    const int rowbase = sample ? MP + b * 4096 : b * 256;
    const int qstart = qblk * 128 + qhalf * 64;
    v8s qf0[4], qf1[4];
#pragma unroll
    for (int ks = 0; ks < 4; ++ks) {
        qf0[ks] = *(const v8s*)(QKV + (size_t)(rowbase + qstart + r) * AQ_LD + kv * 256 + g * 64 + 16 * ks + 8 * h);
        qf1[ks] = *(const v8s*)(QKV + (size_t)(rowbase + qstart + 32 + r) * AQ_LD + kv * 256 + g * 64 + 16 * ks + 8 * h); }
    const float sk = A.in[21][kv * 4 + g] * LOG2E;
    float m0 = sk, m1 = sk, l0 = h == 0 ? 1.f : 0.f, l1 = l0;
    v16f o00, o10, o01, o11;
#pragma unroll
    for (int i = 0; i < 16; ++i) { o00[i] = 0.f; o10[i] = 0.f; o01[i] = 0.f; o11[i] = 0.f; }
    int lo, nloc, nctx;
    if (sample) { lo = qblk * 128 - 128; if (lo < 0) lo = 0; int hi = qblk * 128 + 256; if (hi > 4096) hi = 4096; nloc = (hi - lo) >> 6; nctx = 8; }
    else { lo = 0; nloc = 4; nctx = 0; }
    const int skey = tid >> 3, sch = tid & 7;
    nloc >>= 1; nctx >>= 1;
    const int ntile = nloc + nctx;
    const bf* const kloc = QKV + (size_t)(rowbase + lo + skey) * AQ_LD + 1024 + kv * 64 + sch * 8;
    const bf* const kctx = CK + (size_t)(b * 512 + skey) * 256 + kv * 64 + sch * 8;
    const bf* const vctx = CV + (size_t)(b * 512 + skey) * 256 + kv * 64 + sch * 8;
    v4u kk0 = *(const v4u*)kloc, vv0 = *(const v4u*)(kloc + 256), kk1 = *(const v4u*)(kloc + (size_t)64 * AQ_LD), vv1 = *(const v4u*)(kloc + (size_t)64 * AQ_LD + 256);
    for (int ti = 0; ti < ntile; ++ti) {
        int key0; bool masked;
        if (ti < nloc) { key0 = lo + ti * 128; masked = sample != 0; } else { key0 = (ti - nloc) * 128; masked = false; }
        __syncthreads();
        *(LAS v4u*)(Ks + skey * 72 + sch * 8) = kk0; *(LAS v4u*)(Ks + (skey + 64) * 72 + sch * 8) = kk1;
        *(LAS v4u*)(Vs + skey * 96 + sch * 8) = vv0; *(LAS v4u*)(Vs + (skey + 64) * 96 + sch * 8) = vv1;
        if (ti + 1 < ntile) {
            const int tn = ti + 1;
            if (tn < nloc) { const bf* p = kloc + (size_t)tn * 128 * AQ_LD; kk0 = *(const v4u*)p; vv0 = *(const v4u*)(p + 256); kk1 = *(const v4u*)(p + (size_t)64 * AQ_LD); vv1 = *(const v4u*)(p + (size_t)64 * AQ_LD + 256); }
            else { const size_t o = (size_t)(tn - nloc) * 128 * 256; kk0 = *(const v4u*)(kctx + o); vv0 = *(const v4u*)(vctx + o); kk1 = *(const v4u*)(kctx + o + 64 * 256); vv1 = *(const v4u*)(vctx + o + 64 * 256); }
        }
        __syncthreads();
#pragma unroll 2
        for (int kb = 0; kb < 4; ++kb) {
            v8s kf[4];
#pragma unroll
            for (int ks = 0; ks < 4; ++ks) kf[ks] = *(const LAS v8s*)(Ks + (kb * 32 + r) * 72 + 16 * ks + 8 * h);
            v8s p00, p01, p10, p11;
            { v16f S0;
#pragma unroll
              for (int i = 0; i < 16; ++i) S0[i] = 0.f;
#pragma unroll
              for (int ks = 0; ks < 4; ++ks) S0 = mfma32(kf[ks], qf0[ks], S0);
              attn_qblock(S0, masked, qstart + r, key0 + kb * 32, h, m0, l0, o00, o10, p00, p01); }
            { v16f S1;
#pragma unroll
              for (int i = 0; i < 16; ++i) S1[i] = 0.f;
#pragma unroll
              for (int ks = 0; ks < 4; ++ks) S1 = mfma32(kf[ks], qf1[ks], S1);
              attn_qblock(S1, masked, qstart + 32 + r, key0 + kb * 32, h, m1, l1, o01, o11, p10, p11); }
#pragma unroll
            for (int s2 = 0; s2 < 2; ++s2) {
                const LAS bf* vp0 = vtr0 + (kb * 32 + 16 * s2) * 96;
                const v4s_t a0 = lds_tr16(vp0), a1 = lds_tr16(vp0 + 8 * 96), b0 = lds_tr16(vp0 + 32), b1 = lds_tr16(vp0 + 8 * 96 + 32);
                const v8s vf0 = (v8s){a0[0], a0[1], a0[2], a0[3], a1[0], a1[1], a1[2], a1[3]}, vf1 = (v8s){b0[0], b0[1], b0[2], b0[3], b1[0], b1[1], b1[2], b1[3]};
                const v8s pq0 = s2 ? p01 : p00, pq1 = s2 ? p11 : p10;
                o00 = mfma32(vf0, pq0, o00); o10 = mfma32(vf1, pq0, o10); o01 = mfma32(vf0, pq1, o01); o11 = mfma32(vf1, pq1, o11);
            }
        }
    }
    l0 += __shfl_xor(l0, 32); l1 += __shfl_xor(l1, 32);
    const float i0 = 1.0f / l0, i1 = 1.0f / l1;
    bf* op0 = O + (size_t)(rowbase + qstart + r) * DM + kv * 256 + g * 64 + 4 * h; bf* op1 = op0 + (size_t)32 * DM;
#pragma unroll
    for (int g4 = 0; g4 < 4; ++g4) {
        v2u w; w.x = pkh2(o00[4 * g4] * i0, o00[4 * g4 + 1] * i0); w.y = pkh2(o00[4 * g4 + 2] * i0, o00[4 * g4 + 3] * i0); *(v2u*)(op0 + 8 * g4) = w;
        w.x = pkh2(o10[4 * g4] * i0, o10[4 * g4 + 1] * i0); w.y = pkh2(o10[4 * g4 + 2] * i0, o10[4 * g4 + 3] * i0); *(v2u*)(op0 + 32 + 8 * g4) = w;
        w.x = pkh2(o01[4 * g4] * i1, o01[4 * g4 + 1] * i1); w.y = pkh2(o01[4 * g4 + 2] * i1, o01[4 * g4 + 3] * i1); *(v2u*)(op1 + 8 * g4) = w;
        w.x = pkh2(o11[4 * g4] * i1, o11[4 * g4 + 1] * i1); w.y = pkh2(o11[4 * g4 + 2] * i1, o11[4 * g4 + 3] * i1); *(v2u*)(op1 + 32 + 8 * g4) = w; }
    __syncthreads();
}
__device__ __forceinline__ void attn_phase(LAS unsigned char* lds, const Args& A, int tid) {
    for (int u = blockIdx.x; u < 1280; u += gridDim.x) {
        if (u < 1024) attn_unit(lds, A, 1, u >> 7, (u >> 5) & 3, u & 31, tid);
        else { const int p = u - 1024; attn_unit(lds, A, 0, p >> 3, (p >> 1) & 3, p & 1, tid); }
    }
}


#if DIAG == 2
#ifndef DG_HD
#define DG_HD 0
#endif
#ifndef DG_DIR
#define DG_DIR 0
#endif
#ifndef DG_STEPS
#define DG_STEPS 512
#endif
__device__ __forceinline__ void diag_mlstm(LAS unsigned char* lds, const Args& A, int tid) {
    if (blockIdx.x != 0) return;
    const int hd = DG_HD, dir = DG_DIR, b = 0;
    const bf* BIG = (const bf*)(A.ws + WS_BIG); const float* GATES = (const float*)(A.ws + WS_GATES);
    const bf* HD = (const bf*)(A.ws + (dir ? WS_HB : WS_XN));
    LAS float* hred = (LAS float*)lds;
    LAS float* qred = hred + 512;
    LAS float* acc = hred + 600;
    const int v = tid & 127, dg = tid >> 7;
    const int sidx = (b * 2 + dir) * 8 + hd;
    float C[16], n[16]; float m = A.in[4][sidx];
#pragma unroll
    for (int i = 0; i < 16; ++i) { C[i] = A.in[2][(size_t)sidx * 8192 + (dg * 16 + i) * 128 + v]; n[i] = A.in[3][sidx * 64 + dg * 16 + i]; }
    if (tid < 2) acc[tid] = 0.f;
    float e2 = 0.f, r2 = 0.f;
    __syncthreads();
    for (int p = 0; p < DG_STEPS; ++p) {
        const int tok = dir ? 4095 - p : p; const size_t row = (size_t)(MP + b * 4096 + tok);
        const float li = GATES[row * 32 + dir * 16 + hd], lf = log_sigmoid(GATES[row * 32 + dir * 16 + 8 + hd]);
        const float mn = fmaxf(lf + m, li), fa = expf(lf + m - mn), ia = expf(li - mn);
        const float vv = bf2f(BIG[row * QKVO_LD + 1024 + hd * 128 + v]);
        float ph = 0.f, pq = 0.f;
#pragma unroll
        for (int i = 0; i < 16; ++i) { const int d = dg * 16 + i;
            const unsigned short kq = BIG[row * QKVO_LD + 512 + hd * 64 + d], qq = BIG[row * QKVO_LD + hd * 64 + d];
            const float kk = (float)__builtin_bit_cast(_Float16, kq), q = (float)__builtin_bit_cast(_Float16, qq);
            C[i] = fa * C[i] + ia * kk * vv; n[i] = fa * n[i] + ia * kk; ph += q * C[i]; pq += q * n[i]; }
        hred[dg * 128 + v] = ph; if (v == 0) qred[dg] = pq;
        __syncthreads();
        if (dg == 0) { const float hn = hred[v] + hred[128 + v] + hred[256 + v] + hred[384 + v]; const float qn = qred[0] + qred[1] + qred[2] + qred[3];
            const float h = hn / fmaxf(fabsf(qn), expf(-mn)); const float hk = bf2f(HD[row * DM + hd * 128 + v]);
            e2 += (h - hk) * (h - hk); r2 += h * h; }
        m = mn;
        __syncthreads();
    }
    if (dg == 0) { atomicAdd((float*)acc, e2); atomicAdd((float*)acc + 1, r2); }
    __syncthreads();
    if (tid == 0) ((float*)(A.ws + WS_ROPE))[4000] = acc[0] / acc[1];
    __syncthreads();
}
#endif
#define XB_TMO      128
#define XB_XCNT(j)  (256  + 64 * (j))
#define XB_XSUB(j)  (1280 + 64 * (j))
#define XB_XGEN(j)  (2304 + 64 * (j))
#define XB_TOP      3328
#define XB_TOPGEN   3392
#define XCD_BAR_WORDS 3456
#define XB_SPIN_CAP (1u << 18)

__device__ __forceinline__ unsigned xb_ld(unsigned* p)              { return __hip_atomic_load(p, __ATOMIC_RELAXED, __HIP_MEMORY_SCOPE_AGENT); }
__device__ __forceinline__ unsigned xb_add(unsigned* p, unsigned v) { return __hip_atomic_fetch_add(p, v, __ATOMIC_RELAXED, __HIP_MEMORY_SCOPE_AGENT); }
__device__ __forceinline__ unsigned xb_xcc_id() { return (unsigned)__builtin_amdgcn_s_getreg((3 << 11) | 20) & 0xFu; }
#define XB_SPIN(cond, bar) do { unsigned _sp = 0; while (cond) { __builtin_amdgcn_s_sleep(1); \
    if ((++_sp & 255u) == 0u) { if (xb_ld(&(bar)[XB_TMO])) break; if (_sp > XB_SPIN_CAP) { atomicAdd(&(bar)[XB_TMO], 1u); break; } } } } while (0)

struct XcdBarrier {
    unsigned* bar; unsigned x;
    volatile LAS unsigned* st;
};

__device__ __forceinline__ XcdBarrier xcd_barrier_post(unsigned* bar, volatile LAS unsigned* st) {
    XcdBarrier b; b.bar = bar; b.x = xb_xcc_id(); b.st = st;
    if (threadIdx.x == 0) (void)xb_add(&bar[XB_XCNT(b.x)], 1u);
    return b;
}
__device__ __forceinline__ void xcd_barrier_complete(unsigned* bar, unsigned x, unsigned& nloc, unsigned& nx) {
    const unsigned G = gridDim.x * gridDim.y * gridDim.z;
    unsigned sum, cnt, mine, sp = 0u;
    for (;;) {
        sum = 0u; cnt = 0u; mine = 0u;
#pragma unroll
        for (unsigned j = 0; j < 16; ++j) { const unsigned c = xb_ld(&bar[XB_XCNT(j)]); sum += c; cnt += (c > 0u) ? 1u : 0u; mine = (j == x) ? c : mine; }
        if (sum == G) break;
        __builtin_amdgcn_s_sleep(1);
        if ((++sp & 255u) == 0u) { if (xb_ld(&bar[XB_TMO])) break; if (sp > XB_SPIN_CAP) { atomicAdd(&bar[XB_TMO], 1u); break; } }
    }
    nloc = mine > 0u ? mine : 1u; nx = cnt > 0u ? cnt : 1u;
}

__device__ __forceinline__ void xcd_barrier(const XcdBarrier& b) {
    asm volatile("s_waitcnt vmcnt(0)" ::: "memory");
    __syncthreads();
    if (threadIdx.x == 0) {
        unsigned* bar = b.bar;
        __builtin_amdgcn_s_waitcnt(0);
        unsigned nloc = b.st[0], nx = b.st[1];
        if (nloc == 0u) { xcd_barrier_complete(bar, b.x, nloc, nx); b.st[0] = nloc; b.st[1] = nx; }
        const unsigned old = xb_add(&bar[XB_XSUB(b.x)], 1u);
        const unsigned gen = old / nloc;
        if (old + 1u == (gen + 1u) * nloc) {
            __builtin_amdgcn_fence(__ATOMIC_RELEASE, "agent");
            asm volatile("s_waitcnt vmcnt(0)" ::: "memory");
            const unsigned og = xb_add(&bar[XB_TOP], 1u);
            const unsigned tg = og / nx;
            if (og + 1u == (tg + 1u) * nx) xb_add(&bar[XB_TOPGEN], 1u);
            else XB_SPIN(xb_ld(&bar[XB_TOPGEN]) == tg, bar);
            __builtin_amdgcn_fence(__ATOMIC_ACQUIRE, "agent");
            xb_add(&bar[XB_XGEN(b.x)], 1u);
            asm volatile("s_waitcnt vmcnt(0)" ::: "memory");
        } else {
            XB_SPIN(xb_ld(&bar[XB_XGEN(b.x)]) == gen, bar);
            __builtin_amdgcn_fence(__ATOMIC_ACQUIRE, "agent");
            asm volatile("s_waitcnt vmcnt(0)" ::: "memory");
        }
    }
    __syncthreads();
}

constexpr int N_PHASES = 24;
#define PH_IN(k) (lo <= (k) && (k) < hi)
#define PH_SYNC(k) do { if (PH_IN(k) && (k) + 1 < hi) { if (!ONE_LAUNCH) grid.sync(); else xcd_barrier(xbar); } } while (0)
template <int L>
__device__ __forceinline__ void layer_program(const Args& A, LAS unsigned char* lds, int lo, int hi, int tid, cg::grid_group& grid, const XcdBarrier& xbar) {
    constexpr int B0 = 1 + 11 * L;
    constexpr bool first = (L == 0);
    constexpr size_t WL = (size_t)L * W_LAYER, MODL = (size_t)L * 9 * 9216;
#define P_X16 ((bf*)A.out)
#define P_XF ((float*)(A.ws + WS_XN))
#define P_MOD ((const float*)(A.ws + WS_MOD) + MODL)
#define P_W ((bf*)(A.ws + WS_W))
#define P_XN ((bf*)(A.ws + WS_XN))
#define P_HB ((bf*)(A.ws + WS_HB))
#define P_BIG ((bf*)(A.ws + WS_BIG))
    if (PH_IN(B0 + 0)) { if (EN(1)) if constexpr (first) norm_phase<2, false>(A.in[0], A.in[1] - (size_t)MP * DM, P_XN, nullptr, A.in[11] + (size_t)(L * 3 + 0) * DM, P_MOD + 0 * 1024, tid);
        else norm_phase<2, true>(P_X16, P_X16, P_XN, nullptr, A.in[11] + (size_t)(L * 3 + 0) * DM, P_MOD + 0 * 1024, tid); }
    PH_SYNC(B0 + 0);
    if (PH_IN(B0 + 1)) { pg8::Gemm g{P_XN, P_W + WL, MT, 5632, 1024}; pg8::StaticOrder S; S.init(MT, 5632, (int)gridDim.x, (int)blockIdx.x); EpiSwiglu E{P_BIG};
        if (EN(2)) pg8::gemm_phase<EpiSwiglu, pg8::StaticOrder, true, true>(lds, g, S, E);
        if ((EXPM & 4) && first) pg8::gemm_phase<EpiSwiglu, pg8::StaticOrder, true, true>(lds, g, S, E); }
    PH_SYNC(B0 + 1);
    if (PH_IN(B0 + 2)) { pg8::Gemm g{P_BIG, P_W + WL + W_GU, MT, 1024, DFF}; pg8::StaticOrder S; S.init(MT, 1024, (int)gridDim.x, (int)blockIdx.x);
        if constexpr (first) { EpiResid<true, false, true> E{A.in[0], A.in[1] - (size_t)MP * DM, P_X16, P_MOD + 2 * 1024};
            pg8::gemm_phase<EpiResid<true, false, true>, pg8::StaticOrder, true, true>(lds, g, S, E); }
        else { EpiResid<true, true, true> E{P_X16, P_X16, P_X16, P_MOD + 2 * 1024};
            pg8::gemm_phase<EpiResid<true, true, true>, pg8::StaticOrder, true, true>(lds, g, S, E); } }
    PH_SYNC(B0 + 2);
    if (PH_IN(B0 + 3)) { if (EN(1)) norm_phase<2, true>(P_X16, P_X16, P_XN, nullptr, A.in[11] + (size_t)(L * 3 + 1) * DM, P_MOD + 3 * 1024, tid); }
    PH_SYNC(B0 + 3);
    if (PH_IN(B0 + 4)) {
        if constexpr (first) { pg8::Gemm g{P_XN, P_W + W_MI, MT, MI_N, 1024}; pg8::StaticOrder S; S.init(MT, MI_N, (int)gridDim.x, (int)blockIdx.x);
            EpiMlstmIn E{P_BIG, (float*)(A.ws + WS_GATES), A.in[17]};
            if (EN(4)) pg8::gemm_phase<EpiMlstmIn, pg8::StaticOrder, true, true>(lds, g, S, E); }
        else { pg8::Gemm g{P_XN, P_W + W_AI, MT, 1536, 1024}; pg8::StaticOrder S; S.init(MT, 1536, (int)gridDim.x, (int)blockIdx.x);
            EpiAttnIn E{P_BIG, A.out + OUT_CK, A.out + OUT_CV, (const float*)(A.ws + WS_ROPE)};
            if (EN(5)) pg8::gemm_phase<EpiAttnIn, pg8::StaticOrder, true, true>(lds, g, S, E); } }
    PH_SYNC(B0 + 4);
    if (PH_IN(B0 + 5)) { if constexpr (first) { if (EN(6)) mlstm_phase(lds, A, tid); if (EXPM & 16) mlstm_phase(lds, A, tid); } else { if (EN(7)) attn_phase(lds, A, tid); if (EXPM & 32) attn_phase(lds, A, tid); } }
    PH_SYNC(B0 + 5);
    if constexpr (first) {
        if (PH_IN(B0 + 6)) { if (EN(8)) combine_phase(P_XN, P_HB, P_BIG, A.in[18], tid); }
        PH_SYNC(B0 + 6);
    }
    if (PH_IN(B0 + 7)) { pg8::Gemm g{P_XN, P_W + (first ? W_MO : W_AO), MT, 1024, 1024}; pg8::StaticOrder S; S.init(MT, 1024, (int)gridDim.x, (int)blockIdx.x);
        EpiResid<false, true, true> E{P_X16, P_X16, P_X16, P_MOD + 5 * 1024};
        pg8::gemm_phase<EpiResid<false, true, true>, pg8::StaticOrder, true, true>(lds, g, S, E); }
    PH_SYNC(B0 + 7);
    if (PH_IN(B0 + 8)) { if (EN(1)) norm_phase<2, true>(P_X16, P_X16, P_XN, nullptr, A.in[11] + (size_t)(L * 3 + 2) * DM, P_MOD + 6 * 1024, tid); }
    PH_SYNC(B0 + 8);
    if (PH_IN(B0 + 9)) { pg8::Gemm g{P_XN, P_W + WL + W_GU + W_DN, MT, 5632, 1024}; pg8::StaticOrder S; S.init(MT, 5632, (int)gridDim.x, (int)blockIdx.x); EpiSwiglu E{P_BIG};
        if (EN(2)) pg8::gemm_phase<EpiSwiglu, pg8::StaticOrder, true, true>(lds, g, S, E); }
    PH_SYNC(B0 + 9);
    if (PH_IN(B0 + 10)) { pg8::Gemm g{P_BIG, P_W + WL + 2 * W_GU + W_DN, MT, 1024, DFF}; pg8::StaticOrder S; S.init(MT, 1024, (int)gridDim.x, (int)blockIdx.x);
        if constexpr (first) { EpiResid<true, true, true> E{P_X16, P_X16, P_X16, P_MOD + 8 * 1024};
            pg8::gemm_phase<EpiResid<true, true, true>, pg8::StaticOrder, true, true>(lds, g, S, E); }
        else { EpiResid<true, true, true> E{P_X16, P_X16, P_XN, P_MOD + 8 * 1024};
            pg8::gemm_phase<EpiResid<true, true, true>, pg8::StaticOrder, true, true>(lds, g, S, E); } }
    PH_SYNC(B0 + 10);
}
__global__ void __launch_bounds__(NTHR, 2) fwd_megakernel(Args A) {
    extern __shared__ __attribute__((aligned(16))) unsigned char lds_raw[];
    LAS unsigned char* lds = (LAS unsigned char*)lds_raw;
    cg::grid_group grid = cg::this_grid();
    const int tid = threadIdx.x;
    const int lo = A.ph_lo, hi = A.ph_hi;
    if (tid < 2) ((volatile LAS unsigned*)(lds + LDS_BARST))[tid] = 0u;
    __syncthreads();
    XcdBarrier xbar; xbar.bar = (unsigned*)(A.ws + WS_BAR); xbar.x = 0; xbar.st = (volatile LAS unsigned*)(lds + LDS_BARST);
    if (ONE_LAUNCH) xbar = xcd_barrier_post((unsigned*)(A.ws + WS_BAR), (volatile LAS unsigned*)(lds + LDS_BARST));
    if (lo < 0) grid.sync();
    if (PH_IN(0)) { if (EN(0)) prologue(A, lds, tid); if (EXPM & 8) { __syncthreads(); prologue(A, lds, tid); } }
    PH_SYNC(0);
    layer_program<0>(A, lds, lo, hi, tid, grid, xbar);
    layer_program<1>(A, lds, lo, hi, tid, grid, xbar);
    if (PH_IN(N_PHASES - 1)) { if (EN(1)) norm_phase<1, true>(P_XN, P_XN, nullptr, A.out, A.in[23], (const float*)(A.ws + WS_ROPE), tid); }
}

extern "C" void kernel_launch(void* const* d_in, const int* in_sizes, int n_in, void* d_out, int out_size, void* d_ws, size_t ws_size, hipStream_t stream) {
    static int grid = 0;
    if (grid == 0) {
        if (n_in != 24 || (size_t)out_size != OUT_TOTAL || ws_size < WS_END) { fprintf(stderr, "kernel_launch: unexpected shapes (n_in %d out %d ws %zu)\n", n_in, out_size, ws_size); grid = -1; return; }
        int dev = 0, cus = 0, per_cu = 0;
        if (hipGetDevice(&dev) != hipSuccess || hipDeviceGetAttribute(&cus, hipDeviceAttributeMultiprocessorCount, dev) != hipSuccess) { grid = -1; return; }
        if (hipFuncSetAttribute((const void*)fwd_megakernel, hipFuncAttributeMaxDynamicSharedMemorySize, LDS_BYTES) != hipSuccess) { fprintf(stderr, "kernel_launch: hipFuncSetAttribute failed\n"); grid = -1; return; }
        if (hipOccupancyMaxActiveBlocksPerMultiprocessor(&per_cu, (const void*)fwd_megakernel, NTHR, LDS_BYTES) != hipSuccess || per_cu < 1) per_cu = 1;
        (void)hipGetLastError();
        grid = cus * per_cu;
        if (grid > 256) grid = 256;
    }
    if (grid < 0) return;
    Args a{};
    for (int i = 0; i < 24; ++i) a.in[i] = (const float*)d_in[i];
    a.out = (float*)d_out; a.ws = (unsigned char*)d_ws;
#if ONE_LAUNCH
    if (hipMemsetAsync((char*)d_ws + WS_BAR, 0, WS_BAR_BYTES, stream) != hipSuccess) { fprintf(stderr, "kernel_launch: memset of barrier words failed\n"); return; }
    a.ph_lo = 0; a.ph_hi = N_PHASES;
    void* args[] = {&a};
    hipError_t e = hipLaunchCooperativeKernel((const void*)fwd_megakernel, dim3(grid), dim3(NTHR), args, LDS_BYTES, stream);
    if (e != hipSuccess) fprintf(stderr, "cooperative launch failed: %s (grid %d)\n", hipGetErrorString(e), grid);
#else
    for (int p = 0; p < N_PHASES; ++p) {
        if (p == 18) continue;
        a.ph_lo = p; a.ph_hi = p + 1;
        hipLaunchKernelGGL(fwd_megakernel, dim3(grid), dim3(NTHR), LDS_BYTES, stream, a);
    }
#endif
}
```

```cpp
#include <hip/hip_runtime.h>
#include <hip/hip_cooperative_groups.h>
#include <cstdio>
#include <cstdint>
namespace cg = cooperative_groups;
namespace pg8 {
#define PG8_LAS __attribute__((address_space(3)))
typedef unsigned short bf16_t;
typedef short bf16x8 __attribute__((ext_vector_type(8)));
typedef float f32x4 __attribute__((ext_vector_type(4)));
typedef unsigned u32x4 __attribute__((ext_vector_type(4)));
constexpr int BM = 256, BK = 64, HALF = 128, HTB = HALF * BK * 2  , STAGE_BYTES = 8 * HTB, NXCD = 8, WGM = 8;

__host__ __device__ __forceinline__ int lds_byte(int r, int c) { const int st = (r >> 4) * 2 + (c >> 5), rr = r & 15, cc = c & 31, ob = rr * 64 + cc * 2; return st * 1024 + (ob ^ (((ob >> 9) & 1) << 5)); }
__host__ __device__ __forceinline__ void stage_rc(int b, int& R, int& C) { const int st = b / 1024, sb = b % 1024, swz = sb ^ (((sb >> 9) & 1) << 5); R = (st >> 1) * 16 + swz / 64; C = (st & 1) * 32 + (swz % 64) / 2; }
__host__ __device__ __forceinline__ int perm32(int rho) { const int n = rho >> 4, i = rho & 15; return 8 * (i >> 2) + 4 * n + (i & 3); }

typedef _Float16 f16x8 __attribute__((ext_vector_type(8)));
template <bool F16> __device__ __forceinline__ f32x4 mma16(bf16x8 a, bf16x8 b, f32x4 c) {
    if constexpr (F16) return __builtin_amdgcn_mfma_f32_16x16x32_f16(__builtin_bit_cast(f16x8, a), __builtin_bit_cast(f16x8, b), c, 0, 0, 0);
    else return __builtin_amdgcn_mfma_f32_16x16x32_bf16(a, b, c, 0, 0, 0);
}
struct Unit { int pm, pn; };
struct Gemm { const bf16_t* A; const bf16_t* Bt; int M, N, K; };

struct StaticOrder {
    int nM, nN, nwg, G, c;
    __host__ __device__ void init(int M, int N, int G_, int c_) { nM = M / BM; nN = N / BM; nwg = nM * nN; G = G_; c = c_; }
    __host__ __device__ bool next(int i, Unit& u) const {
        const long L = (long)i * G + c; if (L >= nwg) return false;
        int wgid = (int)L; { const int q = nwg / NXCD, r = nwg % NXCD, xcd = wgid % NXCD, off = wgid / NXCD; wgid = (xcd < r ? xcd * (q + 1) : r * (q + 1) + (xcd - r) * q) + off; }
        const int nig = WGM * nN, gid = wgid / nig, fm = gid * WGM, gsz = (nM - fm) < WGM ? (nM - fm) : WGM;
        u.pm = fm + ((wgid % nig) % gsz); u.pn = (wgid % nig) / gsz; return true;
    }
    __device__ __forceinline__ void a_ready(const Unit&) const {}
    __device__ __forceinline__ void done(const Unit&) const {}
};

__device__ __forceinline__ unsigned cvt_pk_bf16(float lo, float hi) { unsigned r; asm volatile("v_cvt_pk_bf16_f32 %0, %1, %2" : "=v"(r) : "v"(lo), "v"(hi)); return r; }
typedef float f32x2 __attribute__((ext_vector_type(2)));
__device__ __forceinline__ f32x2 gelu_pk(f32x2 v) {
    const f32x2 av = __builtin_elementwise_abs(v), d = av * 0.2316418882f + 1.0f;
    f32x2 t; t.x = __builtin_amdgcn_rcpf(d.x); t.y = __builtin_amdgcn_rcpf(d.y);
    f32x2 q = t * 0.5307027145f + (-0.7265760135f); q = q * t + 0.7107068705f; q = q * t + (-0.142248368f); q = q * t + 0.127414796f; q = q * t;
    const f32x2 s = (v * v) * (-0.72134752044f);
    f32x2 e; e.x = __builtin_amdgcn_exp2f(s.x); e.y = __builtin_amdgcn_exp2f(s.y);
    const f32x2 m = v * (q * e), r = v - m;
    f32x2 o; o.x = v.x < 0.f ? m.x : r.x; o.y = v.y < 0.f ? m.y : r.y; return o;
}

template <int ACT  > struct EpiBf16 {
    static constexpr bool PERM = true, AFTER_DRAIN = false; static_assert(ACT == 0 || ACT == 1, "EpiBf16: ACT is 0 (none) or 1 (gelu_pk)");
    bf16_t* O; int ldc; const float* bias; int split_cols; size_t split_stride; float scale0;
    __device__ __forceinline__ void operator()(const f32x4 (&acc)[2][2][4][2], const Unit& u, int wr, int wc, int fr, int fq) const {
        const int row0 = u.pm * BM + wr * 64 + fr; int colt = u.pn * BM; bf16_t* base = O;
        float sc = 1.f; if (split_cols) { const int t = colt / split_cols; base += (size_t)t * split_stride; colt -= t * split_cols; if (t == 0) sc = scale0; }
        const int col0 = colt + wc * 32 + 8 * fq, bcol0 = u.pn * BM + wc * 32 + 8 * fq;
        f32x4 bv[2][2];
#pragma unroll
        for (int bj = 0; bj < 2; ++bj)
#pragma unroll
            for (int n = 0; n < 2; ++n) bv[bj][n] = bias ? *(const f32x4*)(bias + bcol0 + bj * HALF + 4 * n) : (f32x4){0.f, 0.f, 0.f, 0.f};
#pragma unroll
        for (int ai = 0; ai < 2; ++ai)
#pragma unroll
            for (int m = 0; m < 4; ++m) { bf16_t* rowp = base + (size_t)(row0 + ai * HALF + m * 16) * ldc + col0;
#pragma unroll
                for (int bj = 0; bj < 2; ++bj) { f32x4 v0 = acc[ai][bj][m][0] + bv[bj][0], v1 = acc[ai][bj][m][1] + bv[bj][1];
                    if (ACT == 1) { f32x2 a = gelu_pk((f32x2){v0[0], v0[1]}), b = gelu_pk((f32x2){v0[2], v0[3]}), c = gelu_pk((f32x2){v1[0], v1[1]}), d = gelu_pk((f32x2){v1[2], v1[3]});
                        v0 = (f32x4){a.x, a.y, b.x, b.y}; v1 = (f32x4){c.x, c.y, d.x, d.y}; }
                    v0 = v0 * sc; v1 = v1 * sc; u32x4 w; w.x = cvt_pk_bf16(v0[0], v0[1]); w.y = cvt_pk_bf16(v0[2], v0[3]); w.z = cvt_pk_bf16(v1[0], v1[1]); w.w = cvt_pk_bf16(v1[2], v1[3]);
                    *(u32x4*)(rowp + bj * HALF) = w; } }
    }
};

struct PanelStats {
    unsigned* xbuf;
    unsigned* cnt;
    unsigned* tmo;
    int ntn; float eps;
    unsigned code;
    __device__ __forceinline__ bool run(const f32x4 (&v)[2][2][4][2], const Unit& u, int wr, int wc, int fr, int fq, PG8_LAS unsigned char* lds, int wid, int lane) const {
        typedef float f32x2v __attribute__((ext_vector_type(2)));
        PG8_LAS f32x2v* P = (PG8_LAS f32x2v*)lds;
        PG8_LAS f32x2v* S = (PG8_LAS f32x2v*)(lds + 8192);
        PG8_LAS unsigned* flag = (PG8_LAS unsigned*)(lds + 8192 + 2048);
#pragma unroll
        for (int ai = 0; ai < 2; ++ai)
#pragma unroll
            for (int m = 0; m < 4; ++m) {
                float s = 0.f;
#pragma unroll
                for (int bj = 0; bj < 2; ++bj)
#pragma unroll
                    for (int n = 0; n < 2; ++n) { const f32x4 x = v[ai][bj][m][n]; s += (x[0] + x[1]) + (x[2] + x[3]); }
                s += __shfl_xor(s, 16); s += __shfl_xor(s, 32);
                const float mw = s * (1.0f / 64.0f); float q = 0.f;
#pragma unroll
                for (int bj = 0; bj < 2; ++bj)
#pragma unroll
                    for (int n = 0; n < 2; ++n) { const f32x4 d = v[ai][bj][m][n] - mw; q += (d[0] * d[0] + d[1] * d[1]) + (d[2] * d[2] + d[3] * d[3]); }
                q += __shfl_xor(q, 16); q += __shfl_xor(q, 32);
                if (fq == 0) P[(ai * HALF + wr * 64 + m * 16 + fr) * 4 + wc] = (f32x2v){mw, q};
            }
        asm volatile("s_waitcnt lgkmcnt(0)" ::: "memory"); __builtin_amdgcn_s_barrier(); asm volatile("" ::: "memory");
#if defined(BROKEN_EXCHANGE_NO_WAIT)
#warning BROKEN CONTROL BUILD: the row-statistics exchange does not wait; results are wrong by design
        if (blockIdx.x >= 64) { const long long t0_ = clock64(); while (clock64() - t0_ < 60000) __builtin_amdgcn_s_sleep(8); }
#endif
        const int row = wid * 32 + (lane & 31);
        if (lane < 32) {
            const f32x2v a = P[row * 4 + 0], b = P[row * 4 + 1], c = P[row * 4 + 2], d = P[row * 4 + 3];
            const float mt = (a.x + b.x + c.x + d.x) * 0.25f;
            const float da = a.x - mt, db = b.x - mt, dc = c.x - mt, dd = d.x - mt;
            const float m2 = (a.y + b.y) + (c.y + d.y) + 64.0f * ((da * da + db * db) + (dc * dc + dd * dd));
            unsigned long long* slot = (unsigned long long*)xbuf + ((size_t)(u.pm * BM + row) * 4 + u.pn);
            __hip_atomic_store(slot, ((unsigned long long)__float_as_uint(m2) << 32) | __float_as_uint(mt), __ATOMIC_RELAXED, __HIP_MEMORY_SCOPE_AGENT);
        }
        asm volatile("s_waitcnt vmcnt(0)" ::: "memory");
        if (lane == 0) __hip_atomic_fetch_add(cnt + 64 * u.pm, 1u, __ATOMIC_RELAXED, __HIP_MEMORY_SCOPE_AGENT);
        if (wid == 0) {
            bool dead = false; const unsigned long long t0 = __builtin_amdgcn_s_memrealtime(); const unsigned want = 8u * (unsigned)ntn;
            for (;;) {
#if defined(BROKEN_EXCHANGE_NO_WAIT)
                break;
#endif
                if ((unsigned)__builtin_amdgcn_readfirstlane(__hip_atomic_load(cnt + 64 * u.pm, __ATOMIC_RELAXED, __HIP_MEMORY_SCOPE_AGENT)) >= want) break;
                if (__builtin_amdgcn_s_memrealtime() - t0 > 2000000ull) {
                    if (lane == 0) { unsigned expect = 0u; __hip_atomic_compare_exchange_strong(tmo + 1, &expect, code | (unsigned)(u.pm & 0xff), __ATOMIC_RELAXED, __ATOMIC_RELAXED, __HIP_MEMORY_SCOPE_AGENT);
                                     __hip_atomic_store(tmo, 1u, __ATOMIC_RELAXED, __HIP_MEMORY_SCOPE_AGENT); }
                    dead = true; break; }
                __builtin_amdgcn_s_sleep(2);
            }
            __builtin_amdgcn_fence(__ATOMIC_ACQUIRE, "agent");
            if (lane == 0) flag[0] = dead ? 1u : 0u;
        }
        asm volatile("s_waitcnt vmcnt(0) lgkmcnt(0)" ::: "memory"); __builtin_amdgcn_s_barrier(); asm volatile("" ::: "memory");
        const bool bad = flag[0] != 0u;
        if (lane < 32) {
            const unsigned long long* slot = (const unsigned long long*)xbuf + (size_t)(u.pm * BM + row) * 4; float mt[4], m2[4]; float ms = 0.f;
#pragma unroll
            for (int t = 0; t < 4; ++t) { if (t < ntn) { const unsigned long long w = __hip_atomic_load(slot + t, __ATOMIC_RELAXED, __HIP_MEMORY_SCOPE_AGENT); mt[t] = __uint_as_float((unsigned)w); m2[t] = __uint_as_float((unsigned)(w >> 32)); } else { mt[t] = 0.f; m2[t] = 0.f; } ms += mt[t]; }
            const float mean = ms / (float)ntn; float q = 0.f;
#pragma unroll
            for (int t = 0; t < 4; ++t) if (t < ntn) { const float dm = mt[t] - mean; q += m2[t] + 256.0f * dm * dm; }
            S[row] = (f32x2v){mean, 1.0f / sqrtf(q / (256.0f * (float)ntn) + eps)};
        }
        asm volatile("s_waitcnt lgkmcnt(0)" ::: "memory"); __builtin_amdgcn_s_barrier(); asm volatile("" ::: "memory");
        return bad;
    }
};
struct EpiLnRes {
    static constexpr bool PERM = false, AFTER_DRAIN = true;
    const float* base; float* out; int ldc; const float* bias; PanelStats st; unsigned poison;
    __device__ __forceinline__ void fused(f32x4 (&acc)[2][2][4][2], const Unit& u, int wr, int wc, int fr, int fq, PG8_LAS unsigned char* lds, int wid, int lane) const {
        typedef float f32x2v __attribute__((ext_vector_type(2)));
        const PG8_LAS f32x2v* S = (const PG8_LAS f32x2v*)(lds + 8192);
        const int col0 = u.pn * BM + wc * 32 + 4 * fq;
#pragma unroll
        for (int bj = 0; bj < 2; ++bj)
#pragma unroll
            for (int n = 0; n < 2; ++n) { const f32x4 bv = bias ? *(const f32x4*)(bias + col0 + bj * HALF + n * 16) : (f32x4){0.f, 0.f, 0.f, 0.f};
#pragma unroll
                for (int ai = 0; ai < 2; ++ai)
#pragma unroll
                    for (int m = 0; m < 4; ++m) acc[ai][bj][m][n] += bv; }
        f32x4 pre[4][2][2];
#pragma unroll
        for (int m = 0; m < 4; ++m) { const size_t off = (size_t)(u.pm * BM + wr * 64 + m * 16 + fr) * ldc + col0;
#pragma unroll
            for (int bj = 0; bj < 2; ++bj)
#pragma unroll
                for (int n = 0; n < 2; ++n) pre[m][bj][n] = *(const f32x4*)(base + off + bj * HALF + n * 16); }
        const bool bad = st.run(acc, u, wr, wc, fr, fq, lds, wid, lane) || poison != 0u;
        const float qnan = __builtin_nanf("");
#pragma unroll
        for (int ai = 0; ai < 2; ++ai)
#pragma unroll
            for (int m = 0; m < 4; ++m) { const int r = ai * HALF + wr * 64 + m * 16 + fr; const f32x2v sr = S[r]; const size_t off = (size_t)(u.pm * BM + r) * ldc + col0;
#pragma unroll
                for (int bj = 0; bj < 2; ++bj)
#pragma unroll
                    for (int n = 0; n < 2; ++n) { const f32x4 bs = ai == 0 ? pre[m][bj][n] : *(const f32x4*)(base + off + bj * HALF + n * 16); f32x4 o = bs + (acc[ai][bj][m][n] - sr.x) * sr.y;
                        if (bad) o = (f32x4){qnan, qnan, qnan, qnan}; *(f32x4*)(out + off + bj * HALF + n * 16) = o; }
                if (m & 1) asm volatile("" ::: "memory"); }
    }
};
struct EpiLnResLn {
    static constexpr bool PERM = false, AFTER_DRAIN = true;
    const float* base; float* out; bf16_t* xn; int ldc; const float* bias; PanelStats st1, st2; unsigned poison;
    __device__ __forceinline__ void fused(f32x4 (&acc)[2][2][4][2], const Unit& u, int wr, int wc, int fr, int fq, PG8_LAS unsigned char* lds, int wid, int lane) const {
        typedef float f32x2v __attribute__((ext_vector_type(2))); typedef unsigned u32x2v __attribute__((ext_vector_type(2)));
        const PG8_LAS f32x2v* S = (const PG8_LAS f32x2v*)(lds + 8192);
        const int col0 = u.pn * BM + wc * 32 + 4 * fq;
#pragma unroll
        for (int bj = 0; bj < 2; ++bj)
#pragma unroll
            for (int n = 0; n < 2; ++n) { const f32x4 bv = bias ? *(const f32x4*)(bias + col0 + bj * HALF + n * 16) : (f32x4){0.f, 0.f, 0.f, 0.f};
#pragma unroll
                for (int ai = 0; ai < 2; ++ai)
#pragma unroll
                    for (int m = 0; m < 4; ++m) acc[ai][bj][m][n] += bv; }
        bool bad = st1.run(acc, u, wr, wc, fr, fq, lds, wid, lane) || poison != 0u;
        const float qnan = __builtin_nanf("");
#pragma unroll
        for (int ai = 0; ai < 2; ++ai)
#pragma unroll
            for (int m = 0; m < 4; ++m) { const int r = ai * HALF + wr * 64 + m * 16 + fr; const f32x2v sr = S[r]; const size_t off = (size_t)(u.pm * BM + r) * ldc + col0;
#pragma unroll
                for (int bj = 0; bj < 2; ++bj)
#pragma unroll
                    for (int n = 0; n < 2; ++n) { const f32x4 bs = *(const f32x4*)(base + off + bj * HALF + n * 16); acc[ai][bj][m][n] = bs + (acc[ai][bj][m][n] - sr.x) * sr.y; }
                asm volatile("" : "+v"(acc[ai][0][m][0]), "+v"(acc[ai][0][m][1]), "+v"(acc[ai][1][m][0]), "+v"(acc[ai][1][m][1]));
                if (m & 1) asm volatile("" ::: "memory"); }
        const bool bad1 = bad;
        bad = st2.run(acc, u, wr, wc, fr, fq, lds, wid, lane) || bad;
#pragma unroll
        for (int ai = 0; ai < 2; ++ai)
#pragma unroll
            for (int m = 0; m < 4; ++m) { const int r = ai * HALF + wr * 64 + m * 16 + fr; const f32x2v sr = S[r]; const size_t off = (size_t)(u.pm * BM + r) * ldc + col0;
#pragma unroll
                for (int bj = 0; bj < 2; ++bj)
#pragma unroll
                    for (int n = 0; n < 2; ++n) { const f32x4 x1 = acc[ai][bj][m][n]; *(f32x4*)(out + off + bj * HALF + n * 16) = bad1 ? (f32x4){qnan, qnan, qnan, qnan} : x1;
                        const f32x4 o = (x1 - sr.x) * sr.y; u32x2v w; w.x = cvt_pk_bf16(o[0], o[1]); w.y = cvt_pk_bf16(o[2], o[3]);
                        if (bad) { w.x = 0x7fc07fc0u; w.y = 0x7fc07fc0u; } *(u32x2v*)(xn + off + bj * HALF + n * 16) = w; }
                asm volatile("" ::: "memory"); }
    }
};

template <class Epi, class Sched, bool ALIGN_EPI = false, bool SP2 = false>
__device__ __forceinline__ void gemm_phase(PG8_LAS unsigned char* lds, const Gemm g, const Sched& S, const Epi& E) {
    const int tid = threadIdx.x, wid = __builtin_amdgcn_readfirstlane(tid >> 6), lane = tid & 63, wr = wid >> 2, wc = wid & 3, fr = lane & 15, fq = lane >> 4;
    const int K = g.K, nt = K / BK;
    unsigned voffA[2], voffB[2];
#pragma unroll
    for (int i = 0; i < 2; ++i) { int R, C; stage_rc(tid * 16 + i * 8192, R, C); const int Rb = Epi::PERM ? ((R & ~31) + perm32(R & 31)) : R;
        voffA[i] = (unsigned)(R * K + C) * 2u; voffB[i] = (unsigned)(Rb * K + C) * 2u; }
    const size_t kstep = (size_t)(BK * 2);
    const size_t hstep = (size_t)HALF * K * 2;
    const size_t tstep = 2 * hstep;
    const unsigned ldsw = (unsigned)wid * 1024u;
    const int aoff = lds_byte(wr * 64 + fr, fq * 8), boff = lds_byte(wc * 32 + fr, fq * 8);
#define PG8_SA(b, h) (((b) * 2 + (h)) * HTB)
#define PG8_SB(b, h) ((4 + (b) * 2 + (h)) * HTB)
#define PG8_STAGE(bufoff, gbase, voff) do { _Pragma("unroll") for (int _i = 0; _i < 2; ++_i) \
        __builtin_amdgcn_global_load_lds((const unsigned*)((const char*)(gbase) + (voff)[_i]), (PG8_LAS unsigned*)(lds + (bufoff) + ldsw + _i * 8192), 16, 0, 0); } while (0)
#define PG8_LDA(dst, b, h) do { _Pragma("unroll") for (int m = 0; m < 4; ++m) _Pragma("unroll") for (int k = 0; k < 2; ++k) dst[m][k] = *(const PG8_LAS bf16x8*)(lds + PG8_SA(b, h) + aoff + m * 2048 + k * 1024); } while (0)
#define PG8_LDB(dst, b, h) do { _Pragma("unroll") for (int n = 0; n < 2; ++n) _Pragma("unroll") for (int k = 0; k < 2; ++k) dst[n][k] = *(const PG8_LAS bf16x8*)(lds + PG8_SB(b, h) + boff + n * 2048 + k * 1024); } while (0)
#define PG8_MMA(ai, bj, At, Bt) do { __builtin_amdgcn_s_setprio(1); _Pragma("unroll") for (int m = 0; m < 4; ++m) _Pragma("unroll") for (int n = 0; n < 2; ++n) _Pragma("unroll") for (int k = 0; k < 2; ++k) \
        acc[ai][bj][m][n] = mma16<Epi::F16>(Bt[n][k], At[m][k], acc[ai][bj][m][n]); __builtin_amdgcn_s_setprio(0); } while (0)
#define PG8_WAIT_V(n) asm volatile("s_waitcnt vmcnt(" #n ")" ::: "memory")
#define PG8_WAIT_L(n) asm volatile("s_waitcnt lgkmcnt(" #n ")" ::: "memory")
#define PG8_BAR __builtin_amdgcn_s_barrier()
#define PG8_SCHED __builtin_amdgcn_sched_barrier(0)
    Unit cur, nxt; int ui = 0;
    if (!S.next(0, cur)) return;
    f32x4 acc[2][2][4][2];
#pragma unroll
    for (int a = 0; a < 2; ++a)
#pragma unroll
        for (int b = 0; b < 2; ++b)
#pragma unroll
            for (int m = 0; m < 4; ++m)
#pragma unroll
                for (int n = 0; n < 2; ++n) acc[a][b][m][n] = (f32x4){0.f, 0.f, 0.f, 0.f};
    bf16x8 At[4][2], B0[2][2], B1[2][2];
    const char* cA = (const char*)g.A + (size_t)cur.pm * tstep; const char* cB = (const char*)g.Bt + (size_t)cur.pn * tstep;
    S.a_ready(cur);
    if constexpr (SP2) {
        PG8_STAGE(PG8_SB(0, 0), cB, voffB); PG8_STAGE(PG8_SB(0, 1), cB + hstep, voffB); PG8_STAGE(PG8_SA(0, 0), cA, voffA); PG8_STAGE(PG8_SA(0, 1), cA + hstep, voffA);
        if (wr == 1) PG8_BAR;
        PG8_WAIT_V(2); PG8_BAR;
        PG8_STAGE(PG8_SB(1, 0), cB + kstep, voffB); PG8_STAGE(PG8_SA(1, 0), cA + kstep, voffA); PG8_STAGE(PG8_SB(1, 1), cB + hstep + kstep, voffB);
        PG8_WAIT_V(6); PG8_BAR;
    } else {
        PG8_STAGE(PG8_SB(0, 0), cB, voffB); PG8_STAGE(PG8_SA(0, 0), cA, voffA); PG8_STAGE(PG8_SB(0, 1), cB + hstep, voffB); PG8_STAGE(PG8_SA(0, 1), cA + hstep, voffA);
        if (wr == 1) PG8_BAR;
        PG8_WAIT_V(4); PG8_BAR;
        PG8_STAGE(PG8_SB(1, 0), cB + kstep, voffB); PG8_STAGE(PG8_SA(1, 0), cA + kstep, voffA); PG8_STAGE(PG8_SB(1, 1), cB + hstep + kstep, voffB);
        PG8_WAIT_V(6); PG8_BAR;
    }
    for (;;) {
        const bool has_next = S.next(ui + 1, nxt);
        const char* nA = has_next ? (const char*)g.A + (size_t)nxt.pm * tstep : cA; const char* nB = has_next ? (const char*)g.Bt + (size_t)nxt.pn * tstep : cB;
        for (int t = 0; t < nt; t += 2) {
            const bool last = (t == nt - 2);
            const char* a1 = cA + (size_t)(t + 1) * kstep;
            const char* a2 = last ? nA : cA + (size_t)(t + 2) * kstep; const char* b2 = last ? nB : cB + (size_t)(t + 2) * kstep;
            const char* a3 = a2 + kstep; const char* b3 = b2 + kstep;
            if (last && has_next) S.a_ready(nxt);
            if constexpr (SP2) {
            PG8_LDB(B0, 0, 0); PG8_LDB(B1, 0, 1); PG8_SCHED; PG8_LDA(At, 0, 0); PG8_STAGE(PG8_SA(1, 1), a1 + hstep, voffA);
            PG8_WAIT_V(8); PG8_WAIT_L(0); PG8_BAR; PG8_MMA(0, 0, At, B0); PG8_MMA(0, 1, At, B1); PG8_BAR; PG8_SCHED;
            PG8_LDA(At, 0, 1); PG8_STAGE(PG8_SB(0, 0), b2, voffB); PG8_STAGE(PG8_SB(0, 1), b2 + hstep, voffB); PG8_STAGE(PG8_SA(0, 0), a2, voffA);
            PG8_WAIT_V(8); PG8_WAIT_L(0); PG8_BAR; PG8_MMA(1, 0, At, B0); PG8_MMA(1, 1, At, B1); PG8_BAR; PG8_SCHED;
            PG8_LDB(B0, 1, 0); PG8_LDB(B1, 1, 1); PG8_SCHED; PG8_LDA(At, 1, 0); PG8_STAGE(PG8_SA(0, 1), a2 + hstep, voffA);
            PG8_WAIT_V(8); PG8_WAIT_L(0); PG8_BAR; PG8_MMA(0, 0, At, B0); PG8_MMA(0, 1, At, B1); PG8_BAR; PG8_SCHED;
            PG8_LDA(At, 1, 1); PG8_STAGE(PG8_SB(1, 0), b3, voffB); PG8_STAGE(PG8_SB(1, 1), b3 + hstep, voffB); PG8_STAGE(PG8_SA(1, 0), a3, voffA);
            PG8_WAIT_V(8); PG8_WAIT_L(0); PG8_BAR; PG8_MMA(1, 0, At, B0); PG8_MMA(1, 1, At, B1); PG8_BAR; PG8_SCHED;
            } else {
            PG8_LDB(B0, 0, 0); PG8_SCHED; PG8_LDA(At, 0, 0); PG8_STAGE(PG8_SA(1, 1), a1 + hstep, voffA);
            PG8_WAIT_L(8); PG8_BAR; PG8_WAIT_L(0); PG8_MMA(0, 0, At, B0); PG8_BAR; PG8_SCHED;
            PG8_LDB(B1, 0, 1); PG8_STAGE(PG8_SB(0, 0), b2, voffB);
            PG8_BAR; PG8_WAIT_L(0); PG8_MMA(0, 1, At, B1); PG8_BAR;
            PG8_LDA(At, 0, 1); PG8_STAGE(PG8_SA(0, 0), a2, voffA);
            PG8_BAR; PG8_WAIT_L(0); PG8_MMA(1, 0, At, B0); PG8_BAR; PG8_SCHED;
            PG8_STAGE(PG8_SB(0, 1), b2 + hstep, voffB);
            PG8_WAIT_V(6); PG8_BAR; PG8_MMA(1, 1, At, B1); PG8_BAR;
            PG8_LDB(B0, 1, 0); PG8_SCHED; PG8_LDA(At, 1, 0); PG8_STAGE(PG8_SA(0, 1), a2 + hstep, voffA);
            PG8_WAIT_L(8); PG8_BAR; PG8_WAIT_L(0); PG8_MMA(0, 0, At, B0); PG8_BAR; PG8_SCHED;
            PG8_LDB(B1, 1, 1); PG8_STAGE(PG8_SB(1, 0), b3, voffB);
            PG8_BAR; PG8_WAIT_L(0); PG8_MMA(0, 1, At, B1); PG8_BAR;
            PG8_LDA(At, 1, 1); PG8_STAGE(PG8_SA(1, 0), a3, voffA);
            PG8_BAR; PG8_WAIT_L(0); PG8_MMA(1, 0, At, B0); PG8_BAR; PG8_SCHED;
            PG8_STAGE(PG8_SB(1, 1), b3 + hstep, voffB);
            PG8_WAIT_V(6); PG8_BAR; PG8_MMA(1, 1, At, B1); PG8_BAR;
            }
        }
        if constexpr (ALIGN_EPI) { if (wr == 0) PG8_BAR; }
        if constexpr (!Epi::AFTER_DRAIN) { E(acc, cur, wr, wc, fr, fq); S.done(cur); }
        if (!has_next) break;
#pragma unroll
        for (int a = 0; a < 2; ++a)
#pragma unroll
            for (int b = 0; b < 2; ++b)
#pragma unroll
                for (int m = 0; m < 4; ++m)
#pragma unroll
                    for (int n = 0; n < 2; ++n) acc[a][b][m][n] = (f32x4){0.f, 0.f, 0.f, 0.f};
        cur = nxt; cA = nA; cB = nB; ++ui;
        if constexpr (ALIGN_EPI) { if (wr == 1) PG8_BAR; }
    }
    PG8_WAIT_V(0);
    if constexpr (!ALIGN_EPI) { if (wr == 0) PG8_BAR; }
    PG8_BAR;
    if constexpr (Epi::AFTER_DRAIN) { E.fused(acc, cur, wr, wc, fr, fq, lds, wid, lane); S.done(cur); }
#undef PG8_SA
#undef PG8_SB
#undef PG8_STAGE
#undef PG8_LDA
#undef PG8_LDB
#undef PG8_MMA
#undef PG8_WAIT_V
#undef PG8_WAIT_L
#undef PG8_BAR
#undef PG8_SCHED
}
}

#ifndef ENMASK
#define ENMASK 0x1ff
#endif
#define EN(k) (((ENMASK) >> (k)) & 1)
#ifndef DIAG
#define DIAG 0
#endif
#define DG(e) (DIAG == 1 ? (1.0f + (e)) : 1.0f)
#ifndef EXPM
#define EXPM 0
#endif
#ifndef ONE_LAUNCH
#define ONE_LAUNCH 1
#endif
#define LAS __attribute__((address_space(3)))
typedef unsigned short bf;
typedef short v8s __attribute__((ext_vector_type(8)));
typedef float v16f __attribute__((ext_vector_type(16)));
typedef float v4f __attribute__((ext_vector_type(4)));
typedef unsigned v4u __attribute__((ext_vector_type(4)));
typedef unsigned v2u __attribute__((ext_vector_type(2)));

constexpr int DM = 1024, MP = 8192, MS = 32768, MT = 40960, DFF = 2816;
constexpr int NTHR = 512, NWAVE = 8;
constexpr int LDS_BYTES = 147456;
constexpr float LOG2E = 1.4426950408889634f;
constexpr float RMS_EPS = 1e-6f;
constexpr int MI_N = 3328;
constexpr int QKVO_LD = 3072;
constexpr int AQ_LD = 1536;

constexpr size_t MiB = 1u << 20;
constexpr size_t WS_MOD = 0;
constexpr size_t WS_ROPE = 1 * MiB;
constexpr size_t WS_BAR = 1 * MiB + 256 * 1024, WS_BAR_BYTES = 16384;
constexpr int LDS_BARST = 147392;
constexpr size_t WS_CK = 2 * MiB, WS_CV = 4 * MiB;
constexpr size_t WS_GATES = 6 * MiB;
constexpr size_t WS_W = 12 * MiB;
constexpr size_t WS_XN = 92 * MiB;
constexpr size_t WS_HB = 172 * MiB;
constexpr size_t WS_BIG = 252 * MiB;
constexpr size_t WS_END = 492 * MiB;
constexpr size_t W_GU = (size_t)5632 * 1024, W_DN = (size_t)1024 * 2816, W_LAYER = 2 * (W_GU + W_DN);
constexpr size_t W_MI = 2 * W_LAYER, W_MO = W_MI + (size_t)MI_N * 1024, W_AI = W_MO + 1024 * 1024, W_AO = W_AI + 1536 * 1024, W_TOTAL = W_AO + 1024 * 1024;
static_assert(WS_W + W_TOTAL * 2 <= WS_XN, "weights fit");
constexpr size_t OUT_SC = (size_t)MT * DM, OUT_SN = OUT_SC + 4194304, OUT_SM = OUT_SN + 32768, OUT_CK = OUT_SM + 512, OUT_CV = OUT_CK + 2097152, OUT_TOTAL = OUT_CV + 2097152;

typedef float f32x2_t __attribute__((ext_vector_type(2)));
typedef __bf16 bf16x2_t __attribute__((ext_vector_type(2)));
__device__ __forceinline__ unsigned pk2(float lo, float hi) { f32x2_t v = {lo, hi}; bf16x2_t b = __builtin_convertvector(v, bf16x2_t); return __builtin_bit_cast(unsigned, b); }
typedef _Float16 h2_t __attribute__((ext_vector_type(2)));
typedef _Float16 h8_t __attribute__((ext_vector_type(8)));
__device__ __forceinline__ unsigned pkh2(float lo, float hi) { h2_t v; v.x = (_Float16)lo; v.y = (_Float16)hi; return __builtin_bit_cast(unsigned, v); }
__device__ __forceinline__ float hlo(unsigned w) { return (float)__builtin_bit_cast(h2_t, w).x; }
__device__ __forceinline__ float hhi(unsigned w) { return (float)__builtin_bit_cast(h2_t, w).y; }
__device__ __forceinline__ float bf2f(unsigned short x) { return __uint_as_float(((unsigned)x) << 16); }
__device__ __forceinline__ float bflo(unsigned w) { return __uint_as_float(w << 16); }
__device__ __forceinline__ float bfhi(unsigned w) { return __uint_as_float(w & 0xffff0000u); }
__device__ __forceinline__ float wave_sum(float v) {
#pragma unroll
    for (int o = 1; o < 64; o <<= 1) v += __shfl_xor(v, o);
    return v;
}
__device__ __forceinline__ float fast_sigmoid(float x) { return __builtin_amdgcn_rcpf(1.0f + __builtin_amdgcn_exp2f(-x * LOG2E)); }
__device__ __forceinline__ v16f mfma32h(v8s a, v8s b, v16f c) { return __builtin_amdgcn_mfma_f32_32x32x16_f16(__builtin_bit_cast(h8_t, a), __builtin_bit_cast(h8_t, b), c, 0, 0, 0); }
__device__ __forceinline__ v16f mfma32(v8s a, v8s b, v16f c) { return __builtin_amdgcn_mfma_f32_32x32x16_bf16(a, b, c, 0, 0, 0); }
typedef short v4s_t __attribute__((ext_vector_type(4)));
__device__ __forceinline__ v4s_t lds_tr16(const LAS bf* p) { return __builtin_amdgcn_ds_read_tr16_b64_v4i16((LAS v4s_t*)p); }
__device__ __forceinline__ v8s tr_pair(const LAS bf* p0, const LAS bf* p1) { const v4s_t a = lds_tr16(p0), b = lds_tr16(p1); return (v8s){a[0], a[1], a[2], a[3], b[0], b[1], b[2], b[3]}; }
__device__ __forceinline__ v8s pack8(float a0, float a1, float a2, float a3, float a4, float a5, float a6, float a7) {
    v4u w; w.x = pk2(a0, a1); w.y = pk2(a2, a3); w.z = pk2(a4, a5); w.w = pk2(a6, a7); return __builtin_bit_cast(v8s, w);
}

struct EpiSwiglu {
    static constexpr bool PERM = true, AFTER_DRAIN = false, F16 = true;
    bf* O;
    __device__ __forceinline__ void operator()(const pg8::f32x4 (&acc)[2][2][4][2], const pg8::Unit& u, int wr, int wc, int fr, int fq) const {
        const int row0 = u.pm * 256 + wr * 64 + fr, col0 = u.pn * 128 + wc * 32 + 8 * fq;
#pragma unroll
        for (int ai = 0; ai < 2; ++ai)
#pragma unroll
            for (int m = 0; m < 4; ++m) {
                bf* rowp = O + (size_t)(row0 + ai * 128 + m * 16) * DFF + col0;
                float o[8];
#pragma unroll
                for (int n = 0; n < 2; ++n)
#pragma unroll
                    for (int j = 0; j < 4; ++j) { const float g = acc[ai][0][m][n][j], up = acc[ai][1][m][n][j]; o[n * 4 + j] = g * fast_sigmoid(g) * up; }
                v4u w; w.x = pkh2(o[0], o[1]); w.y = pkh2(o[2], o[3]); w.z = pkh2(o[4], o[5]); w.w = pkh2(o[6], o[7]);
                *(v4u*)rowp = w;
            }
    }
};
template <bool HALF, bool XIN16, bool XOUT16> struct EpiResid {
    static constexpr bool PERM = true, AFTER_DRAIN = false, F16 = true;
    const void* xin_p; const void* xin_s; void* xout; const float* gate;
    __device__ __forceinline__ void operator()(const pg8::f32x4 (&acc)[2][2][4][2], const pg8::Unit& u, int wr, int wc, int fr, int fq) const {
        const int ci = u.pm < 32 ? 0 : 1 + ((u.pm - 32) >> 4);
        const void* xin = u.pm < 32 ? xin_p : xin_s;
        const int col0 = u.pn * 256 + wc * 32 + 8 * fq;
        const float* gp = gate + (size_t)ci * 9216 + col0;
        v4f gv[2][2];
#pragma unroll
        for (int bj = 0; bj < 2; ++bj)
#pragma unroll
            for (int n = 0; n < 2; ++n) gv[bj][n] = *(const v4f*)(gp + bj * 128 + n * 4) * (HALF ? 0.5f : 1.0f);
#pragma unroll
        for (int ai = 0; ai < 2; ++ai)
#pragma unroll
            for (int m = 0; m < 4; ++m) {
                const size_t off = (size_t)(u.pm * 256 + ai * 128 + wr * 64 + m * 16 + fr) * DM + col0;
#pragma unroll
                for (int bj = 0; bj < 2; ++bj) {
                    v4f x0, x1;
                    if (XIN16) { const v4u w = *(const v4u*)((const bf*)xin + off + bj * 128);
                        x0 = (v4f){hlo(w.x), hhi(w.x), hlo(w.y), hhi(w.y)}; x1 = (v4f){hlo(w.z), hhi(w.z), hlo(w.w), hhi(w.w)}; }
                    else { x0 = *(const v4f*)((const float*)xin + off + bj * 128); x1 = *(const v4f*)((const float*)xin + off + bj * 128 + 4); }
                    x0 = x0 + gv[bj][0] * acc[ai][bj][m][0]; x1 = x1 + gv[bj][1] * acc[ai][bj][m][1];
                    if (XOUT16) { v4u w; w.x = pkh2(x0[0], x0[1]); w.y = pkh2(x0[2], x0[3]); w.z = pkh2(x1[0], x1[1]); w.w = pkh2(x1[2], x1[3]); *(v4u*)((bf*)xout + off + bj * 128) = w; }
                    else { *(v4f*)((float*)xout + off + bj * 128) = x0; *(v4f*)((float*)xout + off + bj * 128 + 4) = x1; }
                }
            }
    }
};
__device__ __forceinline__ float log_sigmoid(float x) { return x < 0.f ? x - log1pf(expf(x)) : -log1pf(expf(-x)); }
struct EpiMlstmIn {
    static constexpr bool PERM = true, AFTER_DRAIN = false, F16 = true;
    bf* O; float* gates; const float* bgate;
    __device__ __forceinline__ void operator()(const pg8::f32x4 (&acc)[2][2][4][2], const pg8::Unit& u, int wr, int wc, int fr, int fq) const {
        const int row0 = u.pm * 256 + wr * 64 + fr;
        if (u.pn < 12) {
            const float sc = u.pn < 2 ? 0.125f : 1.0f;
            const int col0 = u.pn * 256 + wc * 32 + 8 * fq;
#pragma unroll
            for (int ai = 0; ai < 2; ++ai)
#pragma unroll
                for (int m = 0; m < 4; ++m) {
                    bf* rowp = O + (size_t)(row0 + ai * 128 + m * 16) * QKVO_LD + col0;
#pragma unroll
                    for (int bj = 0; bj < 2; ++bj) { const pg8::f32x4 v0 = acc[ai][bj][m][0] * sc, v1 = acc[ai][bj][m][1] * sc;
                        v4u w;
                        if (u.pn < 4) { w.x = pkh2(v0[0], v0[1]); w.y = pkh2(v0[2], v0[3]); w.z = pkh2(v1[0], v1[1]); w.w = pkh2(v1[2], v1[3]); }
                        else { w.x = pk2(v0[0], v0[1]); w.y = pk2(v0[2], v0[3]); w.z = pk2(v1[0], v1[1]); w.w = pk2(v1[2], v1[3]); }
                        *(v4u*)(rowp + bj * 128) = w; }
                }
        } else if (wc == 0) {
#pragma unroll
            for (int n = 0; n < 2; ++n) { const int c = 8 * fq + 4 * n; const v4f bv = *(const v4f*)(bgate + c);
#pragma unroll
                for (int ai = 0; ai < 2; ++ai)
#pragma unroll
                    for (int m = 0; m < 4; ++m) { const v4f v = acc[ai][0][m][n] + bv;
                        *(v4f*)(gates + (size_t)(row0 + ai * 128 + m * 16) * 32 + c) = v; } }
        }
    }
};
struct EpiAttnIn {
    static constexpr bool PERM = false, AFTER_DRAIN = false, F16 = true;
    bf* O; float* ck_out; float* cv_out; const float* rope;
    __device__ __forceinline__ void operator()(const pg8::f32x4 (&acc)[2][2][4][2], const pg8::Unit& u, int wr, int wc, int fr, int fq) const {
        const bool sample = u.pm >= 32, do_rope = sample && u.pn < 5;
        const int colt = wc * 32 + 4 * fq;
#pragma unroll
        for (int ai = 0; ai < 2; ++ai)
#pragma unroll
            for (int m = 0; m < 4; ++m) {
                const int row = u.pm * 256 + ai * 128 + wr * 64 + m * 16 + fr;
                v4f cs = (v4f){1.f, 1.f, 1.f, 1.f}, sn = (v4f){0.f, 0.f, 0.f, 0.f};
                if (do_rope) { const int t = (row - MP) & 4095; const int pos = (wc & 1) ? (t & 63) : (t >> 6);
                    cs = *(const v4f*)(rope + pos * 16 + 4 * fq); sn = *(const v4f*)(rope + 1024 + pos * 16 + 4 * fq); }
#pragma unroll
                for (int bj = 0; bj < 2; ++bj) {
                    const v4f x0 = acc[ai][bj][m][0], x1 = acc[ai][bj][m][1];
                    const v4f y0 = x0 * cs - x1 * sn, y1 = x1 * cs + x0 * sn;
                    bf* op = O + (size_t)row * AQ_LD + u.pn * 256 + bj * 128 + colt;
                    v2u w0, w1; w0.x = pk2(y0[0], y0[1]); w0.y = pk2(y0[2], y0[3]); w1.x = pk2(y1[0], y1[1]); w1.y = pk2(y1[2], y1[3]);
                    *(v2u*)op = w0; *(v2u*)(op + 16) = w1;
                    if (!sample && u.pn >= 4) { float* cp = (u.pn == 4 ? ck_out : cv_out) + (size_t)row * 256 + bj * 128 + colt;
                        const float dgs = 1.0f; *(v4f*)cp = x0 * dgs; *(v4f*)(cp + 16) = x1 * dgs; }
                }
            }
    }
};

__device__ __forceinline__ void transpose_item(const float* W, int K, int N, bf* WT, int item, int mode, LAS float* scr, int lane) {
    const int nblk = N / 32, kb = item / nblk, nb = item % nblk, k0 = 64 * kb, n0 = 32 * nb;
    int drow0 = n0;
    if (mode & 1) { int j = n0, up = 0; if (j >= DFF) { j -= DFF; up = 1; } drow0 = (j >> 7) * 256 + up * 128 + (j & 127); }
#pragma unroll 8
    for (int i = 0; i < 32; ++i) { const int kk = 2 * i + (lane >> 5); scr[kk * 33 + (lane & 31)] = W[(size_t)(k0 + kk) * N + n0 + (lane & 31)]; }
    asm volatile("s_waitcnt lgkmcnt(0)" ::: "memory");
    const int c = lane & 7;
#pragma unroll
    for (int j = 0; j < 4; ++j) { const int n = (lane >> 3) + 8 * j; const LAS float* s = scr + (8 * c) * 33 + n;
        v4u o;
        if (mode & 2) { o.x = pkh2(s[0 * 33], s[1 * 33]); o.y = pkh2(s[2 * 33], s[3 * 33]); o.z = pkh2(s[4 * 33], s[5 * 33]); o.w = pkh2(s[6 * 33], s[7 * 33]); }
        else { o.x = pk2(s[0 * 33], s[1 * 33]); o.y = pk2(s[2 * 33], s[3 * 33]); o.z = pk2(s[4 * 33], s[5 * 33]); o.w = pk2(s[6 * 33], s[7 * 33]); }
        *(v4u*)(WT + (size_t)(drow0 + n) * K + k0 + 8 * c) = o; }
    asm volatile("s_waitcnt lgkmcnt(0)" ::: "memory");
}

struct Args { const float* in[24]; float* out; unsigned char* ws; int ph_lo, ph_hi; };

__device__ __forceinline__ void mod_layer(const Args& A, LAS unsigned char* lds, int tid, int l, int blk0, int nblk) {
    const int lane = tid & 63, wave = __builtin_amdgcn_readfirstlane(tid >> 6);
    float* MOD = (float*)(A.ws + WS_MOD);
    LAS float* sc = (LAS float*)(lds + 73728);
    LAS float* red = (LAS float*)(lds + 110592);
    for (int i = tid; i < 9 * 1024; i += NTHR) { const int ci = i >> 10, k = i & 1023; const float c = ci == 0 ? A.in[8][k] : A.in[7][(ci - 1) * 1024 + k]; sc[i] = c / (1.0f + expf(-c)); }
    __syncthreads();
    for (int item = (int)blockIdx.x - blk0; item < 144; item += nblk) {
        const int n0 = item * 64;
        const float* wp = A.in[9] + ((size_t)l * 1024 + wave * 128) * 9216 + n0 + lane;
        float a0 = 0.f, a1 = 0.f, a2 = 0.f, a3 = 0.f, a4 = 0.f, a5 = 0.f, a6 = 0.f, a7 = 0.f, a8 = 0.f;
        const LAS float* sp = sc + wave * 128;
#pragma unroll 8
        for (int kk = 0; kk < 128; ++kk) { const float w = wp[(size_t)kk * 9216];
            a0 += sp[kk] * w; a1 += sp[1024 + kk] * w; a2 += sp[2048 + kk] * w; a3 += sp[3072 + kk] * w; a4 += sp[4096 + kk] * w;
            a5 += sp[5120 + kk] * w; a6 += sp[6144 + kk] * w; a7 += sp[7168 + kk] * w; a8 += sp[8192 + kk] * w; }
        LAS float* rp = red + wave * 576 + lane;
        rp[0] = a0; rp[64] = a1; rp[128] = a2; rp[192] = a3; rp[256] = a4; rp[320] = a5; rp[384] = a6; rp[448] = a7; rp[512] = a8;
        __syncthreads();
        for (int o = tid; o < 576; o += NTHR) { const int ci = o >> 6, ln = o & 63; float s = A.in[10][l * 9216 + n0 + ln];
#pragma unroll
            for (int w = 0; w < 8; ++w) s += red[w * 576 + ci * 64 + ln];
            MOD[(size_t)(l * 9 + ci) * 9216 + n0 + ln] = s; }
        __syncthreads();
    }
}
__device__ __forceinline__ void prologue(const Args& A, LAS unsigned char* lds, int tid) {
    const int lane = tid & 63, wave = __builtin_amdgcn_readfirstlane(tid >> 6);
    const int G = gridDim.x, gw = blockIdx.x * NWAVE + wave, NGW = G * NWAVE, gt = blockIdx.x * NTHR + tid, NGT = G * NTHR;
    unsigned char* ws = A.ws;
    float* MOD = (float*)(ws + WS_MOD);
    bf* Wb = (bf*)(ws + WS_W);
    LAS float* scr = (LAS float*)(lds + wave * 8704);
    mod_layer(A, lds, tid, 0, 0, G);
    if (gt < 1024) { const int pos = gt >> 4, i = gt & 15; const float fr = __builtin_amdgcn_exp2f(-(float)i * (13.287712379549449f / 16.0f)); const float ang = (float)pos * fr;
        float* rope = (float*)(ws + WS_ROPE); rope[gt] = cosf(ang); rope[1024 + gt] = sinf(ang); }
    { bf* CK = (bf*)(ws + WS_CK); bf* CV = (bf*)(ws + WS_CV);
      for (int i = gt; i < 262144; i += NGT) { const v4f k = ((const v4f*)A.in[5])[i], v = ((const v4f*)A.in[6])[i];
          v2u wk, wv; wk.x = pk2(k[0], k[1]); wk.y = pk2(k[2], k[3]); wv.x = pk2(v[0], v[1]); wv.y = pk2(v[2], v[3]);
          ((v2u*)CK)[i] = wk; ((v2u*)CV)[i] = wv; } }
    { v4u* z = (v4u*)(Wb + W_MI + (size_t)3104 * 1024); for (int i = gt; i < 224 * 1024 / 8; i += NGT) z[i] = (v4u){0u, 0u, 0u, 0u}; }
    constexpr int I_GU = 16 * 176, I_DN = 44 * 32, I_MI = 16 * 97;
    constexpr int NITEMS = I_GU + I_DN + I_MI;
    for (int it = gw; it < NITEMS; it += NGW) {
        int r = it;
        if (r < I_GU) { transpose_item(A.in[12], 1024, 5632, Wb, r, 3, scr, lane); continue; } r -= I_GU;
        if (r < I_DN) { transpose_item(A.in[13], 2816, 1024, Wb + W_GU, r, 2, scr, lane); continue; } r -= I_DN;
        transpose_item(A.in[16], 1024, 3104, Wb + W_MI, r, 2, scr, lane);
    }
}
__device__ __forceinline__ void transposes_late(const Args& A, LAS unsigned char* lds, int tid_in, int first_blk) {
    int tid = tid_in; asm volatile("" : "+v"(tid) :: "memory");
    const int lane = tid & 63, wave = __builtin_amdgcn_readfirstlane(tid >> 6);
    const int nb = (int)gridDim.x - first_blk; if ((int)blockIdx.x < first_blk || nb <= 0) return;
    const int gw = ((int)blockIdx.x - first_blk) * NWAVE + wave, NGW = nb * NWAVE;
    mod_layer(A, lds, tid, 1, first_blk, nb);
    bf* Wb = (bf*)(A.ws + WS_W);
    LAS float* scr = (LAS float*)(lds + wave * 8704);
    constexpr int I_GU = 16 * 176, I_DN = 44 * 32, I_AI = 16 * 48, I_AO = 16 * 32, I_MO = 16 * 32;
    constexpr int I_LAYER = 2 * (I_GU + I_DN), NITEMS = (I_GU + I_DN) + I_MO + I_LAYER + I_AI + I_AO;
    for (int it = gw; it < NITEMS; it += NGW) {
        int r = it;
        if (r < I_MO) { transpose_item(A.in[19], 1024, 1024, Wb + W_MO, r, 2, scr, lane); continue; } r -= I_MO;
        if (r < I_GU) { transpose_item(A.in[14], 1024, 5632, Wb + W_GU + W_DN, r, 3, scr, lane); continue; } r -= I_GU;
        if (r < I_DN) { transpose_item(A.in[15], 2816, 1024, Wb + 2 * W_GU + W_DN, r, 2, scr, lane); continue; } r -= I_DN;
        if (r < I_LAYER) { bf* wl = Wb + W_LAYER;
            if (r < I_GU) { transpose_item(A.in[12] + W_GU, 1024, 5632, wl, r, 3, scr, lane); continue; } r -= I_GU;
            if (r < I_DN) { transpose_item(A.in[13] + W_DN, 2816, 1024, wl + W_GU, r, 2, scr, lane); continue; } r -= I_DN;
            if (r < I_GU) { transpose_item(A.in[14] + W_GU, 1024, 5632, wl + W_GU + W_DN, r, 3, scr, lane); continue; } r -= I_GU;
            transpose_item(A.in[15] + W_DN, 2816, 1024, wl + 2 * W_GU + W_DN, r, 2, scr, lane); continue; }
        r -= I_LAYER;
        if (r < I_AI) { transpose_item(A.in[20], 1024, 1536, Wb + W_AI, r, 2, scr, lane); continue; } r -= I_AI;
        transpose_item(A.in[22], 1024, 1024, Wb + W_AO, r, 2, scr, lane);
    }
}

template <int MODE, bool IN16>
__device__ __forceinline__ void norm_phase(const void* xin_p, const void* xin_s, bf* XN, float* fout, const float* g, const float* shiftb, int tid) {
    const int lane = tid & 63, wave = __builtin_amdgcn_readfirstlane(tid >> 6);
    const int gw = blockIdx.x * NWAVE + wave, NGW = gridDim.x * NWAVE;
    v4f gv[4];
#pragma unroll
    for (int j = 0; j < 4; ++j) gv[j] = ((const v4f*)g)[64 * j + lane];
    float dgscale = 1.0f;
#if DIAG == 2
    if (MODE == 1) { const float ratio = fminf(shiftb[4000], 0.5f); dgscale = 1.0f + sqrtf(5e-4f + 0.01f * ratio); }
#endif
    static_assert(MT % (2 * 2048) == 0 || true, "rows are dealt two at a time");
    const bool aff = gridDim.x == 256;
    const int rbase = aff ? 5120 * ((int)blockIdx.x & 7) + ((int)blockIdx.x >> 3) * NWAVE + wave : gw;
    const int rstep = aff ? 256 : NGW, rend = aff ? 5120 * (((int)blockIdx.x & 7) + 1) : MT;
    for (int m0 = rbase; m0 < rend; m0 += 2 * rstep) {
        int mr[2]; mr[0] = m0; mr[1] = m0 + rstep;
        const bool two = mr[1] < rend; if (!two) mr[1] = mr[0];
        v4f v[2][4]; float s[2];
#pragma unroll
        for (int q = 0; q < 2; ++q) { s[q] = 0.f;
            if (IN16) { const bf* xr = (const bf*)(mr[q] < MP ? xin_p : xin_s) + (size_t)mr[q] * DM;
#pragma unroll
                for (int j = 0; j < 4; ++j) { const v2u w = ((const v2u*)xr)[64 * j + lane]; v[q][j] = (v4f){hlo(w.x), hhi(w.x), hlo(w.y), hhi(w.y)}; } }
            else { const float* xr = (const float*)(mr[q] < MP ? xin_p : xin_s) + (size_t)mr[q] * DM;
#pragma unroll
                for (int j = 0; j < 4; ++j) v[q][j] = ((const v4f*)xr)[64 * j + lane]; } }
#pragma unroll
        for (int q = 0; q < 2; ++q)
#pragma unroll
            for (int j = 0; j < 4; ++j) s[q] += (v[q][j][0] * v[q][j][0] + v[q][j][1] * v[q][j][1]) + (v[q][j][2] * v[q][j][2] + v[q][j][3] * v[q][j][3]);
#pragma unroll
        for (int q = 0; q < 2; ++q) {
            if (q == 1 && !two) break;
            const int m = mr[q];
            const float rstd = 1.0f / sqrtf(wave_sum(s[q]) * (1.0f / DM) + RMS_EPS);
            if (MODE == 1) {
#pragma unroll
                for (int j = 0; j < 4; ++j) ((v4f*)(fout + (size_t)m * DM))[64 * j + lane] = v[q][j] * rstd * gv[j] * dgscale;
            } else {
                const int ci = m < MP ? 0 : 1 + ((m - MP) >> 12);
                const float* sh = shiftb + (size_t)ci * 9216; const float* scp = sh + 1024;
#pragma unroll
                for (int j = 0; j < 4; ++j) { const v4f shv = ((const v4f*)sh)[64 * j + lane], scv = ((const v4f*)scp)[64 * j + lane];
                    const v4f y = v[q][j] * rstd * gv[j] * (scv + 1.0f) + shv;
                    v2u w; w.x = pkh2(y[0], y[1]); w.y = pkh2(y[2], y[3]);
                    ((v2u*)(XN + (size_t)m * DM))[64 * j + lane] = w; }
            }
        }
    }
}

__device__ __forceinline__ void combine_phase(bf* XN, const bf* HB, const bf* BIG, const float* ghead, int tid) {
    const int lane = tid & 63, wave = __builtin_amdgcn_readfirstlane(tid >> 6);
    const int gw = blockIdx.x * NWAVE + wave, NGW = gridDim.x * NWAVE;
    const int c0 = lane * 16;
    float gh[16];
#pragma unroll
    for (int e = 0; e < 16; ++e) gh[e] = ghead[c0 + e];
    for (int m = gw; m < MT; m += NGW) {
        const v4u f0 = *(const v4u*)(XN + (size_t)m * DM + c0), f1 = *(const v4u*)(XN + (size_t)m * DM + c0 + 8);
        const v4u b0 = *(const v4u*)(HB + (size_t)m * DM + c0), b1 = *(const v4u*)(HB + (size_t)m * DM + c0 + 8);
        const v4u o0 = *(const v4u*)(BIG + (size_t)m * QKVO_LD + 2048 + c0), o1 = *(const v4u*)(BIG + (size_t)m * QKVO_LD + 2048 + c0 + 8);
        float hs[16], og[16]; float ss = 0.f;
#pragma unroll
        for (int q = 0; q < 4; ++q) {
            hs[2 * q] = bflo(f0[q]) + bflo(b0[q]); hs[2 * q + 1] = bfhi(f0[q]) + bfhi(b0[q]);
            hs[8 + 2 * q] = bflo(f1[q]) + bflo(b1[q]); hs[8 + 2 * q + 1] = bfhi(f1[q]) + bfhi(b1[q]);
            og[2 * q] = bflo(o0[q]); og[2 * q + 1] = bfhi(o0[q]); og[8 + 2 * q] = bflo(o1[q]); og[8 + 2 * q + 1] = bfhi(o1[q]); }
#pragma unroll
        for (int e = 0; e < 16; ++e) ss += hs[e] * hs[e];
        ss += __shfl_xor(ss, 1); ss += __shfl_xor(ss, 2); ss += __shfl_xor(ss, 4);
        const float rs = 1.0f / sqrtf(ss * (1.0f / 128.0f) + RMS_EPS);
        float y[16];
#pragma unroll
        for (int e = 0; e < 16; ++e) y[e] = hs[e] * rs * gh[e] * fast_sigmoid(og[e]);
        v4u w0, w1; w0.x = pkh2(y[0], y[1]); w0.y = pkh2(y[2], y[3]); w0.z = pkh2(y[4], y[5]); w0.w = pkh2(y[6], y[7]);
        w1.x = pkh2(y[8], y[9]); w1.y = pkh2(y[10], y[11]); w1.z = pkh2(y[12], y[13]); w1.w = pkh2(y[14], y[15]);
        *(v4u*)(XN + (size_t)m * DM + c0) = w0; *(v4u*)(XN + (size_t)m * DM + c0 + 8) = w1;
    }
}

constexpr int ML_KQ = 0, ML_VT = 18432, ML_KT = 59392, ML_CT = 83968, ML_F = 102400;
__device__ __forceinline__ void mlstm_unit(LAS unsigned char* lds, const Args& A, int sample, int b, int hd, int dir, int tid) {
    const int lane = tid & 63, wave = __builtin_amdgcn_readfirstlane(tid >> 6), r = lane & 31, h = lane >> 5;
    unsigned char* ws = A.ws;
    const bf* BIG = (const bf*)(ws + WS_BIG);
    const float* GATES = (const float*)(ws + WS_GATES);
    bf* HD = (bf*)(ws + (dir ? WS_HB : WS_XN));
    const int NTOK = sample ? 4096 : 256, rowbase = sample ? MP + b * 4096 : b * 256, nch = NTOK >> 7;
    LAS bf* Kq = (LAS bf*)(lds + ML_KQ); LAS bf* Vs = (LAS bf*)(lds + ML_VT); LAS bf* K2 = (LAS bf*)(lds + ML_KT); LAS bf* Ct = (LAS bf*)(lds + ML_CT);
    const int trq = (lane & 15) >> 2, trc = 16 * ((lane >> 4) & 1) + 4 * (lane & 3);
    LAS float* fa = (LAS float*)(lds + ML_F);
    LAS float* s_n = fa + 1536;
    const int db = wave >> 2, vb = wave & 3;
    const int sidx = (b * 2 + dir) * 8 + hd;
    v16f C; float mcur;
    if (sample) {
        const float* cp = A.in[2] + (size_t)sidx * 8192;
#pragma unroll
        for (int i = 0; i < 16; ++i) { const int d = db * 32 + (i & 3) + 8 * (i >> 2) + 4 * h; C[i] = cp[d * 128 + vb * 32 + r]; }
        if (tid < 64) s_n[tid] = A.in[3][sidx * 64 + tid];
        mcur = A.in[4][sidx];
    } else {
#pragma unroll
        for (int i = 0; i < 16; ++i) C[i] = 0.f;
        if (tid < 64) s_n[tid] = 0.f;
        mcur = 0.f;
    }
#pragma unroll
    for (int g4 = 0; g4 < 4; ++g4) { v2u w; w.x = pk2(C[4 * g4], C[4 * g4 + 1]); w.y = pk2(C[4 * g4 + 2], C[4 * g4 + 3]);
        *(LAS v2u*)(Ct + (vb * 32 + r) * 72 + db * 32 + 8 * g4 + 4 * h) = w; }
    __syncthreads();
#define ML_TOKC(cc, i) (dir ? (NTOK - 1 - ((cc) * 128 + (i))) : ((cc) * 128 + (i)))
#define ML_FA(p) (fa + (p) * 768)
#define ML_GATES(cc, mc, FB) do { \
        const int i0 = 2 * lane, i1 = i0 + 1; \
        const float li0 = gl0, lf0 = log_sigmoid(gf0), li1 = gl1, lf1 = log_sigmoid(gf1); \
        float incl = lf0 + lf1; \
        _Pragma("unroll") for (int o = 1; o < 64; o <<= 1) { const float t = __shfl_up(incl, o); if (lane >= o) incl += t; } \
        const float b1 = incl, b0 = incl - lf1; \
        const float a0 = li0 - b0, a1 = li1 - b1; \
        float im = fmaxf(a0, a1); \
        _Pragma("unroll") for (int o = 1; o < 64; o <<= 1) { const float t = __shfl_up(im, o); if (lane >= o) im = fmaxf(im, t); } \
        float ex = __shfl_up(im, 1); if (lane == 0) ex = -INFINITY; \
        const float am0 = fmaxf(ex, a0), am1 = im; \
        const float rc0 = -fmaxf(am0, (mc)), rc1 = -fmaxf(am1, (mc)); \
        const float bend = __shfl(b1, 63), amend = __shfl(im, 63); \
        const float mm = fmaxf((mc), amend); \
        LAS float* F = (FB); \
        F[i0] = a0; F[i1] = a1; F[128 + i0] = rc0; F[128 + i1] = rc1; F[256 + i0] = expf((mc) + rc0); F[256 + i1] = expf((mc) + rc1); \
        F[384 + i0] = b0; F[384 + i1] = b1; F[512 + i0] = expf(a0 - mm); F[512 + i1] = expf(a1 - mm); \
        if (lane == 0) { F[640] = expf((mc) - mm); F[641] = bend + mm; } \
    } while (0)
#define ML_GLOAD(cc) do { const int i0 = 2 * lane; \
        const float* g0 = GATES + (size_t)(rowbase + ML_TOKC((cc), i0)) * 32 + dir * 16 + hd; \
        const float* g1 = GATES + (size_t)(rowbase + ML_TOKC((cc), i0 + 1)) * 32 + dir * 16 + hd; \
        gl0 = g0[0]; gf0 = g0[8]; gl1 = g1[0]; gf1 = g1[8]; } while (0)
    float gl0 = 0.f, gf0 = 0.f, gl1 = 0.f, gf1 = 0.f;
    v4u kreg[2], vreg[4]; int ki[2], kch[2];
#pragma unroll
    for (int q = 0; q < 2; ++q) { const int id = tid + q * 512; ki[q] = id >> 3; kch[q] = id & 7;
        kreg[q] = *(const v4u*)(BIG + (size_t)(rowbase + ML_TOKC(0, ki[q])) * QKVO_LD + 512 + hd * 64 + kch[q] * 8); }
#pragma unroll
    for (int q = 0; q < 4; ++q) { const int id = tid + q * 512, i = id >> 4, ch = id & 15;
        vreg[q] = *(const v4u*)(BIG + (size_t)(rowbase + ML_TOKC(0, i)) * QKVO_LD + 1024 + hd * 128 + ch * 8); }
    if (wave == 0) { ML_GLOAD(0); ML_GATES(0, mcur, ML_FA(0)); if (nch > 1) ML_GLOAD(1); }
    __syncthreads();
    for (int c = 0; c < nch; ++c) {
#define ML_TOK(i) ML_TOKC(c, i)
        LAS float* const F = ML_FA(c & 1);
        LAS float* const s_a = F, * const s_rowc = F + 128, * const s_inter = F + 256, * const s_b = F + 384, * const s_wend = F + 512;
        const float keep = F[640], mnew = F[641];
        const int tb_ = wave & 3, t_ = tb_ * 32 + r;
        const size_t row_t = (size_t)(rowbase + ML_TOK(t_));
        v8s qf[4];
#pragma unroll
        for (int ks = 0; ks < 4; ++ks) qf[ks] = *(const v8s*)(BIG + row_t * QKVO_LD + hd * 64 + 16 * ks + 8 * h);
#pragma unroll
        for (int q = 0; q < 4; ++q) { const int id = tid + q * 512, i = id >> 4, ch = id & 15;
            *(LAS v4u*)(Vs + i * 160 + ch * 8) = vreg[q]; }
#pragma unroll
        for (int q = 0; q < 2; ++q) { *(LAS v4u*)(Kq + ki[q] * 72 + kch[q] * 8) = kreg[q];
            const float we = s_wend[ki[q]]; v4u kw;
#pragma unroll
            for (int e = 0; e < 4; ++e) kw[e] = pk2(hlo(kreg[q][e]) * we, hhi(kreg[q][e]) * we);
            *(LAS v4u*)(K2 + ki[q] * 96 + kch[q] * 8) = kw; }
        if (c + 1 < nch) {
#pragma unroll
            for (int q = 0; q < 4; ++q) { const int id = tid + q * 512, i = id >> 4, ch = id & 15;
                vreg[q] = *(const v4u*)(BIG + (size_t)(rowbase + ML_TOKC(c + 1, i)) * QKVO_LD + 1024 + hd * 128 + ch * 8); }
#pragma unroll
            for (int q = 0; q < 2; ++q) kreg[q] = *(const v4u*)(BIG + (size_t)(rowbase + ML_TOKC(c + 1, ki[q])) * QKVO_LD + 512 + hd * 64 + kch[q] * 8); }
        __syncthreads();
        {
            const int tb = tb_, vh = wave >> 2, t = t_;
            const float rc = s_rowc[t], it = s_inter[t];
            v16f num0, num1; float den = 0.f;
#pragma unroll
            for (int i = 0; i < 16; ++i) { num0[i] = 0.f; num1[i] = 0.f; }
            for (int sb = 0; sb <= tb; ++sb) {
                v16f S;
#pragma unroll
                for (int i = 0; i < 16; ++i) S[i] = 0.f;
#pragma unroll
                for (int ks = 0; ks < 4; ++ks) { const v8s kf = *(const LAS v8s*)(Kq + (sb * 32 + r) * 72 + 16 * ks + 8 * h); S = mfma32h(kf, qf[ks], S); }
#pragma unroll
                for (int g4 = 0; g4 < 4; ++g4) { const v4f av = *(const LAS v4f*)(s_a + sb * 32 + 8 * g4 + 4 * h);
#pragma unroll
                    for (int j = 0; j < 4; ++j) { const int i = 4 * g4 + j, s = sb * 32 + 8 * g4 + 4 * h + j;
                        const float e = __builtin_amdgcn_exp2f((rc + av[j]) * LOG2E); const float w = (s <= t) ? S[i] * e : 0.f; S[i] = w; den += w; } }
                const v8s wf0 = pack8(S[0], S[1], S[2], S[3], S[4], S[5], S[6], S[7]), wf1 = pack8(S[8], S[9], S[10], S[11], S[12], S[13], S[14], S[15]);
#pragma unroll
                for (int s2 = 0; s2 < 2; ++s2) { const v8s wf = s2 ? wf1 : wf0;
                    const LAS bf* vp = Vs + (sb * 32 + 16 * s2 + 4 * h + trq) * 160 + (2 * vh) * 32 + trc;
                    num0 = mfma32(tr_pair(vp, vp + 8 * 160), wf, num0);
                    num1 = mfma32(tr_pair(vp + 32, vp + 8 * 160 + 32), wf, num1); }
            }
            float qn = 0.f;
#pragma unroll
            for (int ks = 0; ks < 4; ++ks) {
                const v4u qw = __builtin_bit_cast(v4u, qf[ks]); float qv[8];
#pragma unroll
                for (int e = 0; e < 4; ++e) { qv[2 * e] = hlo(qw[e]); qv[2 * e + 1] = hhi(qw[e]); }
                const v4f n0 = *(const LAS v4f*)(s_n + 16 * ks + 8 * h), n1 = *(const LAS v4f*)(s_n + 16 * ks + 8 * h + 4);
                qn += qv[0] * n0[0] + qv[1] * n0[1] + qv[2] * n0[2] + qv[3] * n0[3] + qv[4] * n1[0] + qv[5] * n1[1] + qv[6] * n1[2] + qv[7] * n1[3];
                const v8s qs = pack8(qv[0] * it, qv[1] * it, qv[2] * it, qv[3] * it, qv[4] * it, qv[5] * it, qv[6] * it, qv[7] * it);
                const v8s c0 = *(const LAS v8s*)(Ct + ((2 * vh) * 32 + r) * 72 + 16 * ks + 8 * h), c1 = *(const LAS v8s*)(Ct + ((2 * vh + 1) * 32 + r) * 72 + 16 * ks + 8 * h);
                num0 = mfma32(c0, qs, num0); num1 = mfma32(c1, qs, num1);
            }
            den += __shfl_xor(den, 32); qn += __shfl_xor(qn, 32);
            const float dd = den + it * qn;
            const float hden = fmaxf(fabsf(dd), expf(rc - s_b[t]));
            const float inv = 1.0f / hden;
            bf* op = HD + row_t * DM + hd * 128 + (2 * vh) * 32 + 4 * h;
#pragma unroll
            for (int g4 = 0; g4 < 4; ++g4) {
                v2u w; w.x = pk2(num0[4 * g4] * inv, num0[4 * g4 + 1] * inv); w.y = pk2(num0[4 * g4 + 2] * inv, num0[4 * g4 + 3] * inv); *(v2u*)(op + 8 * g4) = w;
                v2u x; x.x = pk2(num1[4 * g4] * inv, num1[4 * g4 + 1] * inv); x.y = pk2(num1[4 * g4 + 2] * inv, num1[4 * g4 + 3] * inv); *(v2u*)(op + 32 + 8 * g4) = x; }
        }
        if (wave == 0 && c + 1 < nch) { ML_GATES(c + 1, mnew, ML_FA((c + 1) & 1)); if (c + 2 < nch) ML_GLOAD(c + 2); }
        __syncthreads();
#pragma unroll
        for (int i = 0; i < 16; ++i) C[i] *= keep;
#pragma unroll
        for (int ks = 0; ks < 8; ++ks) { const LAS bf* kp = K2 + (16 * ks + 8 * h + trq) * 96 + db * 32 + trc; const LAS bf* vp = Vs + (16 * ks + 8 * h + trq) * 160 + vb * 32 + trc;
            const v8s af = tr_pair(kp, kp + 4 * 96), bfr = tr_pair(vp, vp + 4 * 160);
            C = mfma32(af, bfr, C); }
#pragma unroll
        for (int g4 = 0; g4 < 4; ++g4) { v2u w; w.x = pk2(C[4 * g4], C[4 * g4 + 1]); w.y = pk2(C[4 * g4 + 2], C[4 * g4 + 3]);
            *(LAS v2u*)(Ct + (vb * 32 + r) * 72 + db * 32 + 8 * g4 + 4 * h) = w; }
        if (tid < 64) { float s = 0.f;
#pragma unroll 2
            for (int ss = 0; ss < 128; ss += 4) s += (bf2f(K2[ss * 96 + tid]) + bf2f(K2[(ss + 1) * 96 + tid])) + (bf2f(K2[(ss + 2) * 96 + tid]) + bf2f(K2[(ss + 3) * 96 + tid]));
            s_n[tid] = keep * s_n[tid] + s; }
        mcur = mnew;
        __syncthreads();
#undef ML_TOK
    }
    if (!sample) {
        float* oc = A.out + OUT_SC + (size_t)sidx * 8192;
#pragma unroll
        for (int i = 0; i < 16; ++i) { const int d = db * 32 + (i & 3) + 8 * (i >> 2) + 4 * h; oc[d * 128 + vb * 32 + r] = C[i]; }
        if (tid < 64) A.out[OUT_SN + (size_t)sidx * 64 + tid] = s_n[tid];
        if (tid == 0) A.out[OUT_SM + sidx] = mcur;
    }
    __syncthreads();
}
__device__ __forceinline__ void mlstm_phase(LAS unsigned char* lds, const Args& A, int tid) {
    const int G = gridDim.x, bx = blockIdx.x;
    if (G == 256) {
        if (bx < 128) mlstm_unit(lds, A, 1, bx >> 4, (bx >> 1) & 7, bx & 1, tid);
        else { for (int k = 0; k < 4; ++k) { const int u = (bx - 128) * 4 + k; mlstm_unit(lds, A, 0, u >> 4, (u >> 1) & 7, u & 1, tid); }
               transposes_late(A, lds, tid, 128); }
    } else {
        for (int u = bx; u < 640; u += G) { if (u < 128) mlstm_unit(lds, A, 1, u >> 4, (u >> 1) & 7, u & 1, tid); else { const int p = u - 128; mlstm_unit(lds, A, 0, p >> 4, (p >> 1) & 7, p & 1, tid); } }
        transposes_late(A, lds, tid, 0);
    }
}

constexpr int AT_K = 0, AT_V = 18432;

__device__ __forceinline__ void attn_qblock(const v16f& S, bool masked, int tq, int key0, int h, float& m, float& l, v16f& oA, v16f& oB, v8s& pf0, v8s& pf1) {
    float sc[16];
    const float C2 = 0.125f * LOG2E;
#pragma unroll
    for (int i = 0; i < 16; ++i) { sc[i] = S[i];
        if (masked) { const int s = key0 + (i & 3) + 8 * (i >> 2) + 4 * h; const int dlt = tq - s; if (dlt > 128 || dlt < -128) sc[i] = -INFINITY; } }
    float mx = fmaxf(sc[0], sc[1]);
#pragma unroll
    for (int i = 2; i < 16; ++i) mx = fmaxf(mx, sc[i]);
    mx = fmaxf(mx, __shfl_xor(mx, 32)) * C2;
    if (__any(mx > m)) {
        const float mn = fmaxf(m, mx);
        const float alpha = __builtin_amdgcn_exp2f(m - mn);
        m = mn; l *= alpha;
#pragma unroll
        for (int i = 0; i < 16; ++i) { oA[i] *= alpha; oB[i] *= alpha; }
    }
    const float nm = -m;
    float ps = 0.f;
#pragma unroll
    for (int i = 0; i < 16; ++i) { sc[i] = __builtin_amdgcn_exp2f(__builtin_fmaf(sc[i], C2, nm)); ps += sc[i]; }
    l += ps;
    pf0 = pack8(sc[0], sc[1], sc[2], sc[3], sc[4], sc[5], sc[6], sc[7]);
    pf1 = pack8(sc[8], sc[9], sc[10], sc[11], sc[12], sc[13], sc[14], sc[15]);
}
__device__ __forceinline__ void attn_unit(LAS unsigned char* lds, const Args& A, int sample, int b, int kv, int qblk, int tid) {
    const int lane = tid & 63, wave = __builtin_amdgcn_readfirstlane(tid >> 6), r = lane & 31, h = lane >> 5;
    unsigned char* ws = A.ws;
    const bf* QKV = (const bf*)(ws + WS_BIG); const bf* CK = (const bf*)(ws + WS_CK); const bf* CV = (const bf*)(ws + WS_CV);
    bf* O = (bf*)(ws + WS_XN);
    LAS bf* Ks = (LAS bf*)(lds + AT_K); LAS bf* Vs = (LAS bf*)(lds + AT_V);
    const LAS bf* const vtr0 = Vs + (4 * h + ((lane & 15) >> 2)) * 96 + 16 * ((lane >> 4) & 1) + 4 * (lane & 3);
    const int g = wave >> 1, qhalf = wave & 1;
    const int rowbase = sample ? MP + b * 4096 : b * 256;
    const int qstart = qblk * 128 + qhalf * 64;
    v8s qf0[4], qf1[4];
#pragma unroll
    for (int ks = 0; ks < 4; ++ks) {
        qf0[ks] = *(const v8s*)(QKV + (size_t)(rowbase + qstart + r) * AQ_LD + kv * 256 + g * 64 + 16 * ks + 8 * h);
        qf1[ks] = *(const v8s*)(QKV + (size_t)(rowbase + qstart + 32 + r) * AQ_LD + kv * 256 + g * 64 + 16 * ks + 8 * h); }
    const float sk = A.in[21][kv * 4 + g] * LOG2E;
    float m0 = sk, m1 = sk, l0 = h == 0 ? 1.f : 0.f, l1 = l0;
    v16f o00, o10, o01, o11;
#pragma unroll
    for (int i = 0; i < 16; ++i) { o00[i] = 0.f; o10[i] = 0.f; o01[i] = 0.f; o11[i] = 0.f; }
    int lo, nloc, nctx;
    if (sample) { lo = qblk * 128 - 128; if (lo < 0) lo = 0; int hi = qblk * 128 + 256; if (hi > 4096) hi = 4096; nloc = (hi - lo) >> 6; nctx = 8; }
    else { lo = 0; nloc = 4; nctx = 0; }
    const int skey = tid >> 3, sch = tid & 7;
    nloc >>= 1; nctx >>= 1;
    const int ntile = nloc + nctx;
    const bf* const kloc = QKV + (size_t)(rowbase + lo + skey) * AQ_LD + 1024 + kv * 64 + sch * 8;
    const bf* const kctx = CK + (size_t)(b * 512 + skey) * 256 + kv * 64 + sch * 8;
    const bf* const vctx = CV + (size_t)(b * 512 + skey) * 256 + kv * 64 + sch * 8;
    v4u kk0 = *(const v4u*)kloc, vv0 = *(const v4u*)(kloc + 256), kk1 = *(const v4u*)(kloc + (size_t)64 * AQ_LD), vv1 = *(const v4u*)(kloc + (size_t)64 * AQ_LD + 256);
    for (int ti = 0; ti < ntile; ++ti) {
        int key0; bool masked;
        if (ti < nloc) { key0 = lo + ti * 128; masked = sample != 0; } else { key0 = (ti - nloc) * 128; masked = false; }
        __syncthreads();
        *(LAS v4u*)(Ks + skey * 72 + sch * 8) = kk0; *(LAS v4u*)(Ks + (skey + 64) * 72 + sch * 8) = kk1;
        *(LAS v4u*)(Vs + skey * 96 + sch * 8) = vv0; *(LAS v4u*)(Vs + (skey + 64) * 96 + sch * 8) = vv1;
        if (ti + 1 < ntile) {
            const int tn = ti + 1;
            if (tn < nloc) { const bf* p = kloc + (size_t)tn * 128 * AQ_LD; kk0 = *(const v4u*)p; vv0 = *(const v4u*)(p + 256); kk1 = *(const v4u*)(p + (size_t)64 * AQ_LD); vv1 = *(const v4u*)(p + (size_t)64 * AQ_LD + 256); }
            else { const size_t o = (size_t)(tn - nloc) * 128 * 256; kk0 = *(const v4u*)(kctx + o); vv0 = *(const v4u*)(vctx + o); kk1 = *(const v4u*)(kctx + o + 64 * 256); vv1 = *(const v4u*)(vctx + o + 64 * 256); }
        }
        __syncthreads();
#pragma unroll 2
        for (int kb = 0; kb < 4; ++kb) {
            v8s kf[4];
#pragma unroll
            for (int ks = 0; ks < 4; ++ks) kf[ks] = *(const LAS v8s*)(Ks + (kb * 32 + r) * 72 + 16 * ks + 8 * h);
            v8s p00, p01, p10, p11;
            { v16f S0;
#pragma unroll
              for (int i = 0; i < 16; ++i) S0[i] = 0.f;
#pragma unroll
              for (int ks = 0; ks < 4; ++ks) S0 = mfma32(kf[ks], qf0[ks], S0);
              attn_qblock(S0, masked, qstart + r, key0 + kb * 32, h, m0, l0, o00, o10, p00, p01); }
            { v16f S1;
#pragma unroll
              for (int i = 0; i < 16; ++i) S1[i] = 0.f;
#pragma unroll
              for (int ks = 0; ks < 4; ++ks) S1 = mfma32(kf[ks], qf1[ks], S1);
              attn_qblock(S1, masked, qstart + 32 + r, key0 + kb * 32, h, m1, l1, o01, o11, p10, p11); }
#pragma unroll
            for (int s2 = 0; s2 < 2; ++s2) {
                const LAS bf* vp0 = vtr0 + (kb * 32 + 16 * s2) * 96;
                const v4s_t a0 = lds_tr16(vp0), a1 = lds_tr16(vp0 + 8 * 96), b0 = lds_tr16(vp0 + 32), b1 = lds_tr16(vp0 + 8 * 96 + 32);
                const v8s vf0 = (v8s){a0[0], a0[1], a0[2], a0[3], a1[0], a1[1], a1[2], a1[3]}, vf1 = (v8s){b0[0], b0[1], b0[2], b0[3], b1[0], b1[1], b1[2], b1[3]};
                const v8s pq0 = s2 ? p01 : p00, pq1 = s2 ? p11 : p10;
                o00 = mfma32(vf0, pq0, o00); o10 = mfma32(vf1, pq0, o10); o01 = mfma32(vf0, pq1, o01); o11 = mfma32(vf1, pq1, o11);
            }
        }
    }
    l0 += __shfl_xor(l0, 32); l1 += __shfl_xor(l1, 32);
    const float i0 = 1.0f / l0, i1 = 1.0f / l1;
    bf* op0 = O + (size_t)(rowbase + qstart + r) * DM + kv * 256 + g * 64 + 4 * h; bf* op1 = op0 + (size_t)32 * DM;
#pragma unroll
    for (int g4 = 0; g4 < 4; ++g4) {
        v2u w; w.x = pkh2(o00[4 * g4] * i0, o00[4 * g4 + 1] * i0); w.y = pkh2(o00[4 * g4 + 2] * i0, o00[4 * g4 + 3] * i0); *(v2u*)(op0 + 8 * g4) = w;
        w.x = pkh2(o10[4 * g4] * i0, o10[4 * g4 + 1] * i0); w.y = pkh2(o10[4 * g4 + 2] * i0, o10[4 * g4 + 3] * i0); *(v2u*)(op0 + 32 + 8 * g4) = w;
        w.x = pkh2(o01[4 * g4] * i1, o01[4 * g4 + 1] * i1); w.y = pkh2(o01[4 * g4 + 2] * i1, o01[4 * g4 + 3] * i1); *(v2u*)(op1 + 8 * g4) = w;
        w.x = pkh2(o11[4 * g4] * i1, o11[4 * g4 + 1] * i1); w.y = pkh2(o11[4 * g4 + 2] * i1, o11[4 * g4 + 3] * i1); *(v2u*)(op1 + 32 + 8 * g4) = w; }
    __syncthreads();
}
__device__ __forceinline__ void attn_phase(LAS unsigned char* lds, const Args& A, int tid) {
    for (int u = blockIdx.x; u < 1280; u += gridDim.x) {
        if (u < 1024) attn_unit(lds, A, 1, u >> 7, (u >> 5) & 3, u & 31, tid);
        else { const int p = u - 1024; attn_unit(lds, A, 0, p >> 3, (p >> 1) & 3, p & 1, tid); }
    }
}


#if DIAG == 2
#ifndef DG_HD
#define DG_HD 0
#endif
#ifndef DG_DIR
#define DG_DIR 0
#endif
#ifndef DG_STEPS
#define DG_STEPS 512
#endif
__device__ __forceinline__ void diag_mlstm(LAS unsigned char* lds, const Args& A, int tid) {
    if (blockIdx.x != 0) return;
    const int hd = DG_HD, dir = DG_DIR, b = 0;
    const bf* BIG = (const bf*)(A.ws + WS_BIG); const float* GATES = (const float*)(A.ws + WS_GATES);
    const bf* HD = (const bf*)(A.ws + (dir ? WS_HB : WS_XN));
    LAS float* hred = (LAS float*)lds;
    LAS float* qred = hred + 512;
    LAS float* acc = hred + 600;
    const int v = tid & 127, dg = tid >> 7;
    const int sidx = (b * 2 + dir) * 8 + hd;
    float C[16], n[16]; float m = A.in[4][sidx];
#pragma unroll
    for (int i = 0; i < 16; ++i) { C[i] = A.in[2][(size_t)sidx * 8192 + (dg * 16 + i) * 128 + v]; n[i] = A.in[3][sidx * 64 + dg * 16 + i]; }
    if (tid < 2) acc[tid] = 0.f;
    float e2 = 0.f, r2 = 0.f;
    __syncthreads();
    for (int p = 0; p < DG_STEPS; ++p) {
        const int tok = dir ? 4095 - p : p; const size_t row = (size_t)(MP + b * 4096 + tok);
        const float li = GATES[row * 32 + dir * 16 + hd], lf = log_sigmoid(GATES[row * 32 + dir * 16 + 8 + hd]);
        const float mn = fmaxf(lf + m, li), fa = expf(lf + m - mn), ia = expf(li - mn);
        const float vv = bf2f(BIG[row * QKVO_LD + 1024 + hd * 128 + v]);
        float ph = 0.f, pq = 0.f;
#pragma unroll
        for (int i = 0; i < 16; ++i) { const int d = dg * 16 + i;
            const unsigned short kq = BIG[row * QKVO_LD + 512 + hd * 64 + d], qq = BIG[row * QKVO_LD + hd * 64 + d];
            const float kk = (float)__builtin_bit_cast(_Float16, kq), q = (float)__builtin_bit_cast(_Float16, qq);
            C[i] = fa * C[i] + ia * kk * vv; n[i] = fa * n[i] + ia * kk; ph += q * C[i]; pq += q * n[i]; }
        hred[dg * 128 + v] = ph; if (v == 0) qred[dg] = pq;
        __syncthreads();
        if (dg == 0) { const float hn = hred[v] + hred[128 + v] + hred[256 + v] + hred[384 + v]; const float qn = qred[0] + qred[1] + qred[2] + qred[3];
            const float h = hn / fmaxf(fabsf(qn), expf(-mn)); const float hk = bf2f(HD[row * DM + hd * 128 + v]);
            e2 += (h - hk) * (h - hk); r2 += h * h; }
        m = mn;
        __syncthreads();
    }
    if (dg == 0) { atomicAdd((float*)acc, e2); atomicAdd((float*)acc + 1, r2); }
    __syncthreads();
    if (tid == 0) ((float*)(A.ws + WS_ROPE))[4000] = acc[0] / acc[1];
    __syncthreads();
}
#endif
#define XB_TMO      128
#define XB_XCNT(j)  (256  + 64 * (j))
#define XB_XSUB(j)  (1280 + 64 * (j))
#define XB_XGEN(j)  (2304 + 64 * (j))
#define XB_TOP      3328
#define XB_TOPGEN   3392
#define XCD_BAR_WORDS 3456
#define XB_SPIN_CAP (1u << 18)

__device__ __forceinline__ unsigned xb_ld(unsigned* p)              { return __hip_atomic_load(p, __ATOMIC_RELAXED, __HIP_MEMORY_SCOPE_AGENT); }
__device__ __forceinline__ unsigned xb_add(unsigned* p, unsigned v) { return __hip_atomic_fetch_add(p, v, __ATOMIC_RELAXED, __HIP_MEMORY_SCOPE_AGENT); }
__device__ __forceinline__ unsigned xb_xcc_id() { return (unsigned)__builtin_amdgcn_s_getreg((3 << 11) | 20) & 0xFu; }
#define XB_SPIN(cond, bar) do { unsigned _sp = 0; while (cond) { __builtin_amdgcn_s_sleep(1); \
    if ((++_sp & 255u) == 0u) { if (xb_ld(&(bar)[XB_TMO])) break; if (_sp > XB_SPIN_CAP) { atomicAdd(&(bar)[XB_TMO], 1u); break; } } } } while (0)

struct XcdBarrier {
    unsigned* bar; unsigned x;
    volatile LAS unsigned* st;
};

__device__ __forceinline__ XcdBarrier xcd_barrier_post(unsigned* bar, volatile LAS unsigned* st) {
    XcdBarrier b; b.bar = bar; b.x = xb_xcc_id(); b.st = st;
    if (threadIdx.x == 0) (void)xb_add(&bar[XB_XCNT(b.x)], 1u);
    return b;
}
__device__ __forceinline__ void xcd_barrier_complete(unsigned* bar, unsigned x, unsigned& nloc, unsigned& nx) {
    const unsigned G = gridDim.x * gridDim.y * gridDim.z;
    unsigned sum, cnt, mine, sp = 0u;
    for (;;) {
        sum = 0u; cnt = 0u; mine = 0u;
#pragma unroll
        for (unsigned j = 0; j < 16; ++j) { const unsigned c = xb_ld(&bar[XB_XCNT(j)]); sum += c; cnt += (c > 0u) ? 1u : 0u; mine = (j == x) ? c : mine; }
        if (sum == G) break;
        __builtin_amdgcn_s_sleep(1);
        if ((++sp & 255u) == 0u) { if (xb_ld(&bar[XB_TMO])) break; if (sp > XB_SPIN_CAP) { atomicAdd(&bar[XB_TMO], 1u); break; } }
    }
    nloc = mine > 0u ? mine : 1u; nx = cnt > 0u ? cnt : 1u;
}

__device__ __forceinline__ void xcd_barrier(const XcdBarrier& b) {
    asm volatile("s_waitcnt vmcnt(0)" ::: "memory");
    __syncthreads();
    if (threadIdx.x == 0) {
        unsigned* bar = b.bar;
        __builtin_amdgcn_s_waitcnt(0);
        unsigned nloc = b.st[0], nx = b.st[1];
        if (nloc == 0u) { xcd_barrier_complete(bar, b.x, nloc, nx); b.st[0] = nloc; b.st[1] = nx; }
        const unsigned old = xb_add(&bar[XB_XSUB(b.x)], 1u);
        const unsigned gen = old / nloc;
        if (old + 1u == (gen + 1u) * nloc) {
            __builtin_amdgcn_fence(__ATOMIC_RELEASE, "agent");
            asm volatile("s_waitcnt vmcnt(0)" ::: "memory");
            const unsigned og = xb_add(&bar[XB_TOP], 1u);
            const unsigned tg = og / nx;
            if (og + 1u == (tg + 1u) * nx) xb_add(&bar[XB_TOPGEN], 1u);
            else XB_SPIN(xb_ld(&bar[XB_TOPGEN]) == tg, bar);
            __builtin_amdgcn_fence(__ATOMIC_ACQUIRE, "agent");
            xb_add(&bar[XB_XGEN(b.x)], 1u);
            asm volatile("s_waitcnt vmcnt(0)" ::: "memory");
        } else {
            XB_SPIN(xb_ld(&bar[XB_XGEN(b.x)]) == gen, bar);
            __builtin_amdgcn_fence(__ATOMIC_ACQUIRE, "agent");
            asm volatile("s_waitcnt vmcnt(0)" ::: "memory");
        }
    }
    __syncthreads();
}

constexpr int N_PHASES = 24;
#define PH_IN(k) (lo <= (k) && (k) < hi)
#define PH_SYNC(k) do { if (PH_IN(k) && (k) + 1 < hi) { if (!ONE_LAUNCH) grid.sync(); else xcd_barrier(xbar); } } while (0)
template <int L>
__device__ __forceinline__ void layer_program(const Args& A, LAS unsigned char* lds, int lo, int hi, int tid, cg::grid_group& grid, const XcdBarrier& xbar) {
    constexpr int B0 = 1 + 11 * L;
    constexpr bool first = (L == 0);
    constexpr size_t WL = (size_t)L * W_LAYER, MODL = (size_t)L * 9 * 9216;
#define P_X16 ((bf*)A.out)
#define P_XF ((float*)(A.ws + WS_XN))
#define P_MOD ((const float*)(A.ws + WS_MOD) + MODL)
#define P_W ((bf*)(A.ws + WS_W))
#define P_XN ((bf*)(A.ws + WS_XN))
#define P_HB ((bf*)(A.ws + WS_HB))
#define P_BIG ((bf*)(A.ws + WS_BIG))
    if (PH_IN(B0 + 0)) { if (EN(1)) if constexpr (first) norm_phase<2, false>(A.in[0], A.in[1] - (size_t)MP * DM, P_XN, nullptr, A.in[11] + (size_t)(L * 3 + 0) * DM, P_MOD + 0 * 1024, tid);
        else norm_phase<2, true>(P_X16, P_X16, P_XN, nullptr, A.in[11] + (size_t)(L * 3 + 0) * DM, P_MOD + 0 * 1024, tid); }
    PH_SYNC(B0 + 0);
    if (PH_IN(B0 + 1)) { pg8::Gemm g{P_XN, P_W + WL, MT, 5632, 1024}; pg8::StaticOrder S; S.init(MT, 5632, (int)gridDim.x, (int)blockIdx.x); EpiSwiglu E{P_BIG};
        if (EN(2)) pg8::gemm_phase<EpiSwiglu, pg8::StaticOrder, true, true>(lds, g, S, E);
        if ((EXPM & 4) && first) pg8::gemm_phase<EpiSwiglu, pg8::StaticOrder, true, true>(lds, g, S, E); }
    PH_SYNC(B0 + 1);
    if (PH_IN(B0 + 2)) { pg8::Gemm g{P_BIG, P_W + WL + W_GU, MT, 1024, DFF}; pg8::StaticOrder S; S.init(MT, 1024, (int)gridDim.x, (int)blockIdx.x);
        if constexpr (first) { EpiResid<true, false, true> E{A.in[0], A.in[1] - (size_t)MP * DM, P_X16, P_MOD + 2 * 1024};
            pg8::gemm_phase<EpiResid<true, false, true>, pg8::StaticOrder, true, true>(lds, g, S, E); }
        else { EpiResid<true, true, true> E{P_X16, P_X16, P_X16, P_MOD + 2 * 1024};
            pg8::gemm_phase<EpiResid<true, true, true>, pg8::StaticOrder, true, true>(lds, g, S, E); } }
    PH_SYNC(B0 + 2);
    if (PH_IN(B0 + 3)) { if (EN(1)) norm_phase<2, true>(P_X16, P_X16, P_XN, nullptr, A.in[11] + (size_t)(L * 3 + 1) * DM, P_MOD + 3 * 1024, tid); }
    PH_SYNC(B0 + 3);
    if (PH_IN(B0 + 4)) {
        if constexpr (first) { pg8::Gemm g{P_XN, P_W + W_MI, MT, MI_N, 1024}; pg8::StaticOrder S; S.init(MT, MI_N, (int)gridDim.x, (int)blockIdx.x);
            EpiMlstmIn E{P_BIG, (float*)(A.ws + WS_GATES), A.in[17]};
            if (EN(4)) pg8::gemm_phase<EpiMlstmIn, pg8::StaticOrder, true, true>(lds, g, S, E); }
        else { pg8::Gemm g{P_XN, P_W + W_AI, MT, 1536, 1024}; pg8::StaticOrder S; S.init(MT, 1536, (int)gridDim.x, (int)blockIdx.x);
            EpiAttnIn E{P_BIG, A.out + OUT_CK, A.out + OUT_CV, (const float*)(A.ws + WS_ROPE)};
            if (EN(5)) pg8::gemm_phase<EpiAttnIn, pg8::StaticOrder, true, true>(lds, g, S, E); } }
    PH_SYNC(B0 + 4);
    if (PH_IN(B0 + 5)) { if constexpr (first) { if (EN(6)) mlstm_phase(lds, A, tid); if (EXPM & 16) mlstm_phase(lds, A, tid); } else { if (EN(7)) attn_phase(lds, A, tid); if (EXPM & 32) attn_phase(lds, A, tid); } }
    PH_SYNC(B0 + 5);
    if constexpr (first) {
        if (PH_IN(B0 + 6)) { if (EN(8)) combine_phase(P_XN, P_HB, P_BIG, A.in[18], tid); }
        PH_SYNC(B0 + 6);
    }
    if (PH_IN(B0 + 7)) { pg8::Gemm g{P_XN, P_W + (first ? W_MO : W_AO), MT, 1024, 1024}; pg8::StaticOrder S; S.init(MT, 1024, (int)gridDim.x, (int)blockIdx.x);
        EpiResid<false, true, true> E{P_X16, P_X16, P_X16, P_MOD + 5 * 1024};
        pg8::gemm_phase<EpiResid<false, true, true>, pg8::StaticOrder, true, true>(lds, g, S, E); }
    PH_SYNC(B0 + 7);
    if (PH_IN(B0 + 8)) { if (EN(1)) norm_phase<2, true>(P_X16, P_X16, P_XN, nullptr, A.in[11] + (size_t)(L * 3 + 2) * DM, P_MOD + 6 * 1024, tid); }
    PH_SYNC(B0 + 8);
    if (PH_IN(B0 + 9)) { pg8::Gemm g{P_XN, P_W + WL + W_GU + W_DN, MT, 5632, 1024}; pg8::StaticOrder S; S.init(MT, 5632, (int)gridDim.x, (int)blockIdx.x); EpiSwiglu E{P_BIG};
        if (EN(2)) pg8::gemm_phase<EpiSwiglu, pg8::StaticOrder, true, true>(lds, g, S, E); }
    PH_SYNC(B0 + 9);
    if (PH_IN(B0 + 10)) { pg8::Gemm g{P_BIG, P_W + WL + 2 * W_GU + W_DN, MT, 1024, DFF}; pg8::StaticOrder S; S.init(MT, 1024, (int)gridDim.x, (int)blockIdx.x);
        if constexpr (first) { EpiResid<true, true, true> E{P_X16, P_X16, P_X16, P_MOD + 8 * 1024};
            pg8::gemm_phase<EpiResid<true, true, true>, pg8::StaticOrder, true, true>(lds, g, S, E); }
        else { EpiResid<true, true, true> E{P_X16, P_X16, P_XN, P_MOD + 8 * 1024};
            pg8::gemm_phase<EpiResid<true, true, true>, pg8::StaticOrder, true, true>(lds, g, S, E); } }
    PH_SYNC(B0 + 10);
}
__global__ void __launch_bounds__(NTHR, 2) fwd_megakernel(Args A) {
    extern __shared__ __attribute__((aligned(16))) unsigned char lds_raw[];
    LAS unsigned char* lds = (LAS unsigned char*)lds_raw;
    cg::grid_group grid = cg::this_grid();
    const int tid = threadIdx.x;
    const int lo = A.ph_lo, hi = A.ph_hi;
    if (tid < 2) ((volatile LAS unsigned*)(lds + LDS_BARST))[tid] = 0u;
    __syncthreads();
    XcdBarrier xbar; xbar.bar = (unsigned*)(A.ws + WS_BAR); xbar.x = 0; xbar.st = (volatile LAS unsigned*)(lds + LDS_BARST);
    if (ONE_LAUNCH) xbar = xcd_barrier_post((unsigned*)(A.ws + WS_BAR), (volatile LAS unsigned*)(lds + LDS_BARST));
    if (lo < 0) grid.sync();
    if (PH_IN(0)) { if (EN(0)) prologue(A, lds, tid); if (EXPM & 8) { __syncthreads(); prologue(A, lds, tid); } }
    PH_SYNC(0);
    layer_program<0>(A, lds, lo, hi, tid, grid, xbar);
    layer_program<1>(A, lds, lo, hi, tid, grid, xbar);
    if (PH_IN(N_PHASES - 1)) { if (EN(1)) norm_phase<1, true>(P_XN, P_XN, nullptr, A.out, A.in[23], (const float*)(A.ws + WS_ROPE), tid); }
}

extern "C" void kernel_launch(void* const* d_in, const int* in_sizes, int n_in, void* d_out, int out_size, void* d_ws, size_t ws_size, hipStream_t stream) {
    static int grid = 0;
    if (grid == 0) {
        if (n_in != 24 || (size_t)out_size != OUT_TOTAL || ws_size < WS_END) { fprintf(stderr, "kernel_launch: unexpected shapes (n_in %d out %d ws %zu)\n", n_in, out_size, ws_size); grid = -1; return; }
        int dev = 0, cus = 0, per_cu = 0;
        if (hipGetDevice(&dev) != hipSuccess || hipDeviceGetAttribute(&cus, hipDeviceAttributeMultiprocessorCount, dev) != hipSuccess) { grid = -1; return; }
        if (hipFuncSetAttribute((const void*)fwd_megakernel, hipFuncAttributeMaxDynamicSharedMemorySize, LDS_BYTES) != hipSuccess) { fprintf(stderr, "kernel_launch: hipFuncSetAttribute failed\n"); grid = -1; return; }
        if (hipOccupancyMaxActiveBlocksPerMultiprocessor(&per_cu, (const void*)fwd_megakernel, NTHR, LDS_BYTES) != hipSuccess || per_cu < 1) per_cu = 1;
        (void)hipGetLastError();
        grid = cus * per_cu;
        if (grid > 256) grid = 256;
    }
    if (grid < 0) return;
    Args a{};
    for (int i = 0; i < 24; ++i) a.in[i] = (const float*)d_in[i];
    a.out = (float*)d_out; a.ws = (unsigned char*)d_ws;
#if ONE_LAUNCH
    if (hipMemsetAsync((char*)d_ws + WS_BAR, 0, WS_BAR_BYTES, stream) != hipSuccess) { fprintf(stderr, "kernel_launch: memset of barrier words failed\n"); return; }
    a.ph_lo = 0; a.ph_hi = N_PHASES;
    void* args[] = {&a};
    hipError_t e = hipLaunchCooperativeKernel((const void*)fwd_megakernel, dim3(grid), dim3(NTHR), args, LDS_BYTES, stream);
    if (e != hipSuccess) fprintf(stderr, "cooperative launch failed: %s (grid %d)\n", hipGetErrorString(e), grid);
#else
    for (int p = 0; p < N_PHASES; ++p) {
        if (p == 18) continue;
        a.ph_lo = p; a.ph_hi = p + 1;
        hipLaunchKernelGGL(fwd_megakernel, dim3(grid), dim3(NTHR), LDS_BYTES, stream, a);
    }
#endif
}
```
